# Optimizing an MI355X kernel written in HIP

```python
import jax
import jax.numpy as jnp
from jax import lax
import numpy as np


D_MODEL = 1024
BATCH = 8
SEQ = 2048
DEPTH = 4

CHUNK = 64
HEAD_DIM = 64
D_RWKV = 512
D_ATT = 512
D_MIX = D_RWKV + D_ATT
N_RWKV_HEADS = D_RWKV // HEAD_DIM
N_ATT_HEADS = D_ATT // HEAD_DIM
LORA_W = 64
LORA_A = 64
N_LEFT_CHUNKS = 8
BAND = (N_LEFT_CHUNKS + 1) * CHUNK
REL_CLIP = 128
N_REL = CHUNK + REL_CLIP
RMS_EPS = 1e-6
GN_EPS = 64e-5
D_SHIFT = 4 * D_RWKV + LORA_W + LORA_A
D_IN = D_SHIFT + 4 * D_ATT

kernel_name = 'hybrid_rwkv7_chunkattn_adaln_trunk'


def rms_norm(x, g):
    x32 = x.astype(jnp.float32)
    y = x32 * lax.rsqrt(jnp.mean(x32 * x32, axis=-1, keepdims=True) + RMS_EPS)
    return y.astype(x.dtype) * g


def token_shift(p, mu):
    prev = jnp.pad(p, ((0, 0), (1, 0), (0, 0)))[:, :-1]
    return p + mu * (prev - p)


def rwkv7_step(state, inp):
    r_t, w_t, k_t, v_t, a_t, b_t = inp
    sa = jnp.einsum('bhij,bhj->bhi', state, a_t)
    state = state * w_t[:, :, None, :] + sa[..., None] * b_t[:, :, None, :] + v_t[..., None] * k_t[:, :, None, :]
    y = jnp.einsum('bhij,bhj->bhi', state, r_t)
    return state, y


def rwkv7_mix(ps, w0, w2, a0, a2, k_k, k_a, r_k, lnx_g, lnx_b):
    b_, s_, _ = ps.shape
    f32 = jnp.float32
    r, k, v, g, wd, ad = jnp.split(ps, [D_RWKV, 2 * D_RWKV, 3 * D_RWKV, 4 * D_RWKV, 4 * D_RWKV + LORA_W], axis=-1)
    w_log = -jax.nn.softplus(-(w0 + jnp.tanh(wd) @ w2).astype(f32)) - 0.5
    decay = jnp.exp(-jnp.exp(w_log))
    a = jax.nn.sigmoid((a0 + ad @ a2).astype(f32))
    heads = lambda t: t.astype(f32).reshape(b_, s_, N_RWKV_HEADS, HEAD_DIM)
    r, k, v, decay, a = heads(r), heads(k), heads(v), heads(decay), heads(a)
    kk = k * k_k.astype(f32).reshape(N_RWKV_HEADS, HEAD_DIM)
    kk = kk / jnp.maximum(jnp.sqrt(jnp.sum(kk * kk, axis=-1, keepdims=True)), 1e-12)
    k = k * (1.0 + (a - 1.0) * k_a.astype(f32).reshape(N_RWKV_HEADS, HEAD_DIM))
    seq_first = lambda t: jnp.moveaxis(t, 1, 0)
    state0 = jnp.zeros((b_, N_RWKV_HEADS, HEAD_DIM, HEAD_DIM), f32)
    _, y = lax.scan(rwkv7_step, state0, (seq_first(r), seq_first(decay), seq_first(k), seq_first(v), seq_first(-kk), seq_first(kk * a)))
    y = jnp.moveaxis(y, 0, 1)
    mean = jnp.mean(y, axis=-1, keepdims=True)
    yc = y - mean
    y = yc * lax.rsqrt(jnp.mean(yc * yc, axis=-1, keepdims=True) + GN_EPS)
    y = y.reshape(b_, s_, D_RWKV) * lnx_g.astype(f32) + lnx_b.astype(f32)
    bonus = jnp.sum(r * k * r_k.astype(f32), axis=-1, keepdims=True) * v
    y = y + bonus.reshape(b_, s_, D_RWKV)
    return y.astype(ps.dtype), g


def chunk_band_attention(q, k, v, q_g, k_g, rel_bias):
    b_, s_, _ = q.shape
    nc = s_ // CHUNK
    pad = N_LEFT_CHUNKS * CHUNK
    def heads(t):
        return t.reshape(b_, s_, N_ATT_HEADS, HEAD_DIM).transpose(0, 2, 1, 3)
    q = heads(rms_norm(q.reshape(b_, s_, N_ATT_HEADS, HEAD_DIM), q_g).reshape(b_, s_, D_ATT))
    k = heads(rms_norm(k.reshape(b_, s_, N_ATT_HEADS, HEAD_DIM), k_g).reshape(b_, s_, D_ATT))
    v = heads(v)
    qc = q.reshape(b_, N_ATT_HEADS, nc, CHUNK, HEAD_DIM)
    def band(t):
        tp = jnp.pad(t, ((0, 0), (0, 0), (pad, 0), (0, 0))).reshape(b_, N_ATT_HEADS, nc + N_LEFT_CHUNKS, CHUNK, HEAD_DIM)
        return jnp.concatenate([tp[:, :, i:i + nc] for i in range(N_LEFT_CHUNKS + 1)], axis=3)
    kb, vb = band(k), band(v)
    s = jnp.einsum('bhnqd,bhnkd->bhnqk', qc, kb).astype(jnp.float32) * (HEAD_DIM ** -0.5)
    dist = jnp.arange(CHUNK)[:, None] + pad - jnp.arange(BAND)[None, :]
    rel_idx = jnp.clip(dist, -(CHUNK - 1), REL_CLIP) + (CHUNK - 1)
    bias = rel_bias[:, rel_idx].astype(jnp.float32)
    valid = (jnp.arange(nc)[:, None] * CHUNK + jnp.arange(BAND)[None, :] - pad) >= 0
    s = s + bias[None, :, None]
    s = jnp.where(valid[None, None, :, None, :], s, -1e30)
    p = jax.nn.softmax(s, axis=-1).astype(v.dtype)
    o = jnp.einsum('bhnqk,bhnkd->bhnqd', p, vb)
    return o.reshape(b_, N_ATT_HEADS, s_, HEAD_DIM).transpose(0, 2, 1, 3).reshape(b_, s_, D_ATT)


def setup_inputs(seed: int = 0) -> dict:
    key = jax.random.key(seed)
    ks = jax.random.split(key, 22)
    n = lambda i, shape: jax.random.normal(ks[i], shape, jnp.float32)
    L = DEPTH
    return {
        'x': n(0, (BATCH, SEQ, D_MODEL)),
        'c': n(1, (BATCH, D_MODEL)),
        'norm_g': 1.0 + 0.1 * n(2, (L, D_MODEL)),
        'w_ada': n(3, (L, D_MODEL, 3 * D_MODEL)) * (0.5 * D_MODEL ** -0.5),
        'b_ada': 0.02 * n(4, (L, 3 * D_MODEL)),
        'w_in': n(5, (L, D_MODEL, D_IN)) * (D_MODEL ** -0.5),
        'mu_shift': jax.random.uniform(ks[6], (L, D_SHIFT), jnp.float32),
        'w0': -1.0 + 0.5 * n(7, (L, D_RWKV)),
        'w2': n(8, (L, LORA_W, D_RWKV)) * (0.5 * LORA_W ** -0.5),
        'a0': 0.5 * n(9, (L, D_RWKV)),
        'a2': n(10, (L, LORA_A, D_RWKV)) * (0.5 * LORA_A ** -0.5),
        'k_k': 0.85 + 0.05 * n(11, (L, D_RWKV)),
        'k_a': 1.0 + 0.05 * n(12, (L, D_RWKV)),
        'r_k': 0.1 * n(13, (L, N_RWKV_HEADS, HEAD_DIM)),
        'lnx_g': 1.0 + 0.1 * n(14, (L, D_RWKV)),
        'lnx_b': 0.02 * n(15, (L, D_RWKV)),
        'q_norm_g': 1.0 + 0.1 * n(16, (L, HEAD_DIM)),
        'k_norm_g': 1.0 + 0.1 * n(17, (L, HEAD_DIM)),
        'rel_bias': 0.5 * n(18, (L, N_ATT_HEADS, N_REL)),
        'w_out': n(19, (L, D_MIX, D_MODEL)) * (D_MIX ** -0.5),
    }


def reference(x, c, norm_g, w_ada, b_ada, w_in, mu_shift, w0, w2, a0, a2, k_k, k_a, r_k, lnx_g, lnx_b, q_norm_g, k_norm_g, rel_bias, w_out):
    c_act = jax.nn.silu(c)
    for l in range(DEPTH):
        mod = c_act @ w_ada[l] + b_ada[l]
        shift, scale, gate = jnp.split(mod, 3, axis=-1)
        h = rms_norm(x, norm_g[l]) * (1.0 + scale[:, None, :]) + shift[:, None, :]
        proj = h @ w_in[l]
        ps = token_shift(proj[..., :D_SHIFT], mu_shift[l])
        pa = proj[..., D_SHIFT:]
        y_r, g_r = rwkv7_mix(ps, w0[l], w2[l], a0[l], a2[l], k_k[l], k_a[l], r_k[l], lnx_g[l], lnx_b[l])
        q, ka, va, g_a = jnp.split(pa, 4, axis=-1)
        y_a = chunk_band_attention(q, ka, va, q_norm_g[l], k_norm_g[l], rel_bias[l])
        y = jnp.concatenate([y_r * jax.nn.silu(g_r), y_a * jax.nn.silu(g_a)], axis=-1)
        x = x + gate[:, None, :] * (y @ w_out[l])
    return x
```

```cpp
#include <hip/hip_runtime.h>
#include <hip/hip_cooperative_groups.h>
#include <cstdio>
#include <cstdint>
namespace cg = cooperative_groups;
namespace pg8 {
#define PG8_LAS __attribute__((address_space(3)))
typedef unsigned short bf16_t;
typedef short bf16x8 __attribute__((ext_vector_type(8)));
typedef _Float16 f16x8 __attribute__((ext_vector_type(8)));
typedef float f32x4 __attribute__((ext_vector_type(4)));
typedef unsigned u32x4 __attribute__((ext_vector_type(4)));
constexpr int BM = 256, BK = 64, HALF = 128, HTB = HALF * BK * 2  , STAGE_BYTES = 8 * HTB, NXCD = 8, WGM = 8;

__host__ __device__ __forceinline__ int lds_byte(int r, int c) { const int st = (r >> 4) * 2 + (c >> 5), rr = r & 15, cc = c & 31, ob = rr * 64 + cc * 2; return st * 1024 + (ob ^ (((ob >> 9) & 1) << 5)); }
__host__ __device__ __forceinline__ void stage_rc(int b, int& R, int& C) { const int st = b / 1024, sb = b % 1024, swz = sb ^ (((sb >> 9) & 1) << 5); R = (st >> 1) * 16 + swz / 64; C = (st & 1) * 32 + (swz % 64) / 2; }
__host__ __device__ __forceinline__ int perm32(int rho) { const int n = rho >> 4, i = rho & 15; return 8 * (i >> 2) + 4 * n + (i & 3); }

struct Unit { int pm, pn, ord; };
struct Gemm { const bf16_t* A; const bf16_t* Bt; int M, N, K; };

struct StaticOrder {
    int nM, nN, nwg, G, c;
    __host__ __device__ void init(int M, int N, int G_, int c_) { nM = M / BM; nN = N / BM; nwg = nM * nN; G = G_; c = c_; }
    __host__ __device__ bool next(int i, Unit& u) const {
        const long L = (long)i * G + c; if (L >= nwg) return false;
        int wgid = (int)L; { const int q = nwg / NXCD, r = nwg % NXCD, xcd = wgid % NXCD, off = wgid / NXCD; wgid = (xcd < r ? xcd * (q + 1) : r * (q + 1) + (xcd - r) * q) + off; }
        const int nig = WGM * nN, gid = wgid / nig, fm = gid * WGM, gsz = (nM - fm) < WGM ? (nM - fm) : WGM;
        u.pm = fm + ((wgid % nig) % gsz); u.pn = (wgid % nig) / gsz; u.ord = i; return true;
    }
    __device__ __forceinline__ void a_ready(const Unit&) const {}
    __device__ __forceinline__ void done(const Unit&) const {}
};


template <class Epi, class Sched, bool ALIGN_EPI = false, bool SP2 = false>
__device__ __forceinline__ void gemm_phase(PG8_LAS unsigned char* lds, const Gemm g, const Sched& S, const Epi& E) {
    int tid_ = threadIdx.x; asm volatile("" : "+v"(tid_));
    const int tid = tid_, wid = __builtin_amdgcn_readfirstlane(tid >> 6), lane = tid & 63, wr = wid >> 2, wc = wid & 3, fr = lane & 15, fq = lane >> 4;
    const int K = g.K, nt = K / BK;
    unsigned voffA[2], voffB[2];
#pragma unroll
    for (int i = 0; i < 2; ++i) { int R, C; stage_rc(tid * 16 + i * 8192, R, C); const int Rb = Epi::PERM ? ((R & ~31) + perm32(R & 31)) : R;
        voffA[i] = (unsigned)(R * K + C) * 2u; voffB[i] = (unsigned)(Rb * K + C) * 2u; }
    const size_t kstep = (size_t)(BK * 2);
    const size_t hstep = (size_t)HALF * K * 2;
    const size_t tstep = 2 * hstep;
    const unsigned ldsw = (unsigned)wid * 1024u;
    const int aoff = lds_byte(wr * 64 + fr, fq * 8), boff = lds_byte(wc * 32 + fr, fq * 8);
#define PG8_SA(b, h) (((b) * 2 + (h)) * HTB)
#define PG8_SB(b, h) ((4 + (b) * 2 + (h)) * HTB)
#define PG8_STAGE(bufoff, gbase, voff) do { _Pragma("unroll") for (int _i = 0; _i < 2; ++_i) \
        __builtin_amdgcn_global_load_lds((const unsigned*)((const char*)(gbase) + (voff)[_i]), (PG8_LAS unsigned*)(lds + (bufoff) + ldsw + _i * 8192), 16, 0, 0); } while (0)
#define PG8_LDA(dst, b, h) do { _Pragma("unroll") for (int m = 0; m < 4; ++m) _Pragma("unroll") for (int k = 0; k < 2; ++k) dst[m][k] = *(const PG8_LAS f16x8*)(lds + PG8_SA(b, h) + aoff + m * 2048 + k * 1024); } while (0)
#define PG8_LDB(dst, b, h) do { _Pragma("unroll") for (int n = 0; n < 2; ++n) _Pragma("unroll") for (int k = 0; k < 2; ++k) dst[n][k] = *(const PG8_LAS f16x8*)(lds + PG8_SB(b, h) + boff + n * 2048 + k * 1024); } while (0)
#define PG8_MMA(ai, bj, At, Bt) do { __builtin_amdgcn_s_setprio(1); _Pragma("unroll") for (int m = 0; m < 4; ++m) _Pragma("unroll") for (int n = 0; n < 2; ++n) _Pragma("unroll") for (int k = 0; k < 2; ++k) \
        acc[ai][bj][m][n] = __builtin_amdgcn_mfma_f32_16x16x32_f16(Bt[n][k], At[m][k], acc[ai][bj][m][n], 0, 0, 0); __builtin_amdgcn_s_setprio(0); } while (0)
#define PG8_WAIT_V(n) asm volatile("s_waitcnt vmcnt(" #n ")" ::: "memory")
#define PG8_WAIT_L(n) asm volatile("s_waitcnt lgkmcnt(" #n ")" ::: "memory")
#define PG8_BAR __builtin_amdgcn_s_barrier()
#define PG8_SCHED __builtin_amdgcn_sched_barrier(0)
    Unit cur, nxt; int ui = 0;
    if (!S.next(0, cur)) return;
    f32x4 acc[2][2][4][2];
#pragma unroll
    for (int a = 0; a < 2; ++a)
#pragma unroll
        for (int b = 0; b < 2; ++b)
#pragma unroll
            for (int m = 0; m < 4; ++m)
#pragma unroll
                for (int n = 0; n < 2; ++n) acc[a][b][m][n] = (f32x4){0.f, 0.f, 0.f, 0.f};
    f16x8 At[4][2], B0[2][2], B1[2][2];
    const char* cA = (const char*)g.A + (size_t)cur.pm * tstep; const char* cB = (const char*)g.Bt + (size_t)cur.pn * tstep;
    S.a_ready(cur);
    if constexpr (SP2) {
        PG8_STAGE(PG8_SB(0, 0), cB, voffB); PG8_STAGE(PG8_SB(0, 1), cB + hstep, voffB); PG8_STAGE(PG8_SA(0, 0), cA, voffA); PG8_STAGE(PG8_SA(0, 1), cA + hstep, voffA);
        if (wr == 1) PG8_BAR;
        PG8_WAIT_V(2); PG8_BAR;
        PG8_STAGE(PG8_SB(1, 0), cB + kstep, voffB); PG8_STAGE(PG8_SA(1, 0), cA + kstep, voffA); PG8_STAGE(PG8_SB(1, 1), cB + hstep + kstep, voffB);
        PG8_WAIT_V(6); PG8_BAR;
    } else {
        PG8_STAGE(PG8_SB(0, 0), cB, voffB); PG8_STAGE(PG8_SA(0, 0), cA, voffA); PG8_STAGE(PG8_SB(0, 1), cB + hstep, voffB); PG8_STAGE(PG8_SA(0, 1), cA + hstep, voffA);
        if (wr == 1) PG8_BAR;
        PG8_WAIT_V(4); PG8_BAR;
        PG8_STAGE(PG8_SB(1, 0), cB + kstep, voffB); PG8_STAGE(PG8_SA(1, 0), cA + kstep, voffA); PG8_STAGE(PG8_SB(1, 1), cB + hstep + kstep, voffB);
        PG8_WAIT_V(6); PG8_BAR;
    }
    for (;;) {
        const bool has_next = S.next(ui + 1, nxt);
        const char* nA = has_next ? (const char*)g.A + (size_t)nxt.pm * tstep : cA; const char* nB = has_next ? (const char*)g.Bt + (size_t)nxt.pn * tstep : cB;
        for (int t = 0; t < nt; t += 2) {
            const bool last = (t == nt - 2);
            const char* a1 = cA + (size_t)(t + 1) * kstep;
            const char* a2 = last ? nA : cA + (size_t)(t + 2) * kstep; const char* b2 = last ? nB : cB + (size_t)(t + 2) * kstep;
            const char* a3 = a2 + kstep; const char* b3 = b2 + kstep;
            if (last && has_next) S.a_ready(nxt);
            if constexpr (SP2) {
            PG8_LDB(B0, 0, 0); PG8_LDB(B1, 0, 1); PG8_SCHED; PG8_LDA(At, 0, 0); PG8_STAGE(PG8_SA(1, 1), a1 + hstep, voffA);
            PG8_WAIT_V(8); PG8_WAIT_L(0); PG8_BAR; PG8_MMA(0, 0, At, B0); PG8_MMA(0, 1, At, B1); PG8_BAR; PG8_SCHED;
            PG8_LDA(At, 0, 1); PG8_STAGE(PG8_SB(0, 0), b2, voffB); PG8_STAGE(PG8_SB(0, 1), b2 + hstep, voffB); PG8_STAGE(PG8_SA(0, 0), a2, voffA);
            PG8_WAIT_V(8); PG8_WAIT_L(0); PG8_BAR; PG8_MMA(1, 0, At, B0); PG8_MMA(1, 1, At, B1); PG8_BAR; PG8_SCHED;
            PG8_LDB(B0, 1, 0); PG8_LDB(B1, 1, 1); PG8_SCHED; PG8_LDA(At, 1, 0); PG8_STAGE(PG8_SA(0, 1), a2 + hstep, voffA);
            PG8_WAIT_V(8); PG8_WAIT_L(0); PG8_BAR; PG8_MMA(0, 0, At, B0); PG8_MMA(0, 1, At, B1); PG8_BAR; PG8_SCHED;
            PG8_LDA(At, 1, 1); PG8_STAGE(PG8_SB(1, 0), b3, voffB); PG8_STAGE(PG8_SB(1, 1), b3 + hstep, voffB); PG8_STAGE(PG8_SA(1, 0), a3, voffA);
            PG8_WAIT_V(8); PG8_WAIT_L(0); PG8_BAR; PG8_MMA(1, 0, At, B0); PG8_MMA(1, 1, At, B1); PG8_BAR; PG8_SCHED;
            } else {
            PG8_LDB(B0, 0, 0); PG8_SCHED; PG8_LDA(At, 0, 0); PG8_STAGE(PG8_SA(1, 1), a1 + hstep, voffA);
            PG8_WAIT_L(8); PG8_BAR; PG8_WAIT_L(0); PG8_MMA(0, 0, At, B0); PG8_BAR; PG8_SCHED;
            PG8_LDB(B1, 0, 1); PG8_STAGE(PG8_SB(0, 0), b2, voffB);
            PG8_BAR; PG8_WAIT_L(0); PG8_MMA(0, 1, At, B1); PG8_BAR;
            PG8_LDA(At, 0, 1); PG8_STAGE(PG8_SA(0, 0), a2, voffA);
            PG8_BAR; PG8_WAIT_L(0); PG8_MMA(1, 0, At, B0); PG8_BAR; PG8_SCHED;
            PG8_STAGE(PG8_SB(0, 1), b2 + hstep, voffB);
            PG8_WAIT_V(6); PG8_BAR; PG8_MMA(1, 1, At, B1); PG8_BAR;
            PG8_LDB(B0, 1, 0); PG8_SCHED; PG8_LDA(At, 1, 0); PG8_STAGE(PG8_SA(0, 1), a2 + hstep, voffA);
            PG8_WAIT_L(8); PG8_BAR; PG8_WAIT_L(0); PG8_MMA(0, 0, At, B0); PG8_BAR; PG8_SCHED;
            PG8_LDB(B1, 1, 1); PG8_STAGE(PG8_SB(1, 0), b3, voffB);
            PG8_BAR; PG8_WAIT_L(0); PG8_MMA(0, 1, At, B1); PG8_BAR;
            PG8_LDA(At, 1, 1); PG8_STAGE(PG8_SA(1, 0), a3, voffA);
            PG8_BAR; PG8_WAIT_L(0); PG8_MMA(1, 0, At, B0); PG8_BAR; PG8_SCHED;
            PG8_STAGE(PG8_SB(1, 1), b3 + hstep, voffB);
            PG8_WAIT_V(6); PG8_BAR; PG8_MMA(1, 1, At, B1); PG8_BAR;
            }
        }
        if constexpr (ALIGN_EPI) { if (wr == 0) PG8_BAR; }
        if constexpr (!Epi::AFTER_DRAIN) { E(acc, cur, wr, wc, fr, fq); S.done(cur); }
        if (!has_next) break;
#pragma unroll
        for (int a = 0; a < 2; ++a)
#pragma unroll
            for (int b = 0; b < 2; ++b)
#pragma unroll
                for (int m = 0; m < 4; ++m)
#pragma unroll
                    for (int n = 0; n < 2; ++n) acc[a][b][m][n] = (f32x4){0.f, 0.f, 0.f, 0.f};
        cur = nxt; cA = nA; cB = nB; ++ui;
        if constexpr (ALIGN_EPI) { if (wr == 1) PG8_BAR; }
    }
    PG8_WAIT_V(0);
    if constexpr (!ALIGN_EPI) { if (wr == 0) PG8_BAR; }
    PG8_BAR;
    if constexpr (Epi::AFTER_DRAIN) { E.fused(acc, cur, wr, wc, fr, fq, lds, wid, lane); S.done(cur); }
#undef PG8_SA
#undef PG8_SB
#undef PG8_STAGE
#undef PG8_LDA
#undef PG8_LDB
#undef PG8_MMA
#undef PG8_WAIT_V
#undef PG8_WAIT_L
#undef PG8_BAR
#undef PG8_SCHED
}
}


constexpr int D = 1024, NB = 8, S = 2048, NL = 4, M = NB * S;
constexpr int DIN = 4224, DSH = 2176, DR = 512, NH = 8, HD = 64, NREL = 192;
constexpr int NP = 4352;
constexpr int PC_R = 0, PC_K = 512, PC_V = 1024, PC_G = 1536, PC_WD = 2048, PC_AD = 2112, PC_Q = 2304, PC_KA = 2816, PC_VA = 3328, PC_GA = 3840;
constexpr int NWAVES = 8, NTHR = 512;
constexpr size_t MiB = 1u << 20;
constexpr size_t WS_CTL = 0, WS_MOD = 1 * MiB, WS_SW = 2 * MiB, WS_PART = 3 * MiB, WS_WINT = 4 * MiB, WS_WOUTT = 38 * MiB, WS_AX = 46 * MiB, WS_YB = 78 * MiB, WS_PROJ = 110 * MiB, WS_END = 246 * MiB;
constexpr int LDS_BYTES = 147456;
constexpr int LDS_RSTD = 131072;

#define GAS __attribute__((address_space(1)))
#define LAS __attribute__((address_space(3)))
typedef unsigned short u16;
typedef float f32x4 __attribute__((ext_vector_type(4)));
typedef float f32x2 __attribute__((ext_vector_type(2)));
typedef unsigned u32x4 __attribute__((ext_vector_type(4)));
typedef unsigned u32x2 __attribute__((ext_vector_type(2)));
typedef _Float16 f16x2 __attribute__((ext_vector_type(2)));
typedef _Float16 f16x8 __attribute__((ext_vector_type(8)));

__device__ __forceinline__ unsigned pk_f16(float lo, float hi) { f32x2 v = {lo, hi}; f16x2 h = __builtin_convertvector(v, f16x2); return __builtin_bit_cast(unsigned, h); }
__device__ __forceinline__ float h2f(u16 h) { return (float)__builtin_bit_cast(_Float16, h); }
__device__ __forceinline__ u16 f2h(float f) { return __builtin_bit_cast(u16, (_Float16)f); }
__device__ __forceinline__ float wave_sum(float v) {
#pragma unroll
    for (int o = 1; o < 64; o <<= 1) v += __shfl_xor(v, o);
    return v;
}
__device__ __forceinline__ float sigmoidf_(float x) { return 1.f / (1.f + __expf(-x)); }

struct Params {
    const float *x, *c, *norm_g, *w_ada, *b_ada, *w_in, *mu, *w0, *w2, *a0, *a2, *k_k, *k_a, *r_k, *lnx_g, *lnx_b, *qg, *kg, *rel_bias, *w_out;
    float* out; unsigned char* ws; int ph_lo, ph_hi;
};

struct EpiProj {
    static constexpr bool PERM = true, AFTER_DRAIN = false;
    u16* O; const float* sw; const LAS float* rstd;
    __device__ __forceinline__ void operator()(const pg8::f32x4 (&acc)[2][2][4][2], const pg8::Unit& u, int wr, int wc, int fr, int fq) const {
        const int b = u.pm >> 3, col0 = u.pn * 256 + wc * 32 + 8 * fq;
        f32x4 sv[2][2];
#pragma unroll
        for (int bj = 0; bj < 2; ++bj)
#pragma unroll
            for (int n = 0; n < 2; ++n) sv[bj][n] = *(const f32x4*)(sw + (size_t)b * NP + col0 + bj * 128 + 4 * n);
#pragma unroll
        for (int ai = 0; ai < 2; ++ai)
#pragma unroll
            for (int m = 0; m < 4; ++m) {
                const int rl = ai * 128 + wr * 64 + m * 16 + fr; const float rs = rstd[u.ord * 256 + rl];
                u16* rowp = O + (size_t)(u.pm * 256 + rl) * NP + col0;
#pragma unroll
                for (int bj = 0; bj < 2; ++bj) {
                    const f32x4 v0 = acc[ai][bj][m][0] * rs + sv[bj][0], v1 = acc[ai][bj][m][1] * rs + sv[bj][1];
                    u32x4 w; w.x = pk_f16(v0[0], v0[1]); w.y = pk_f16(v0[2], v0[3]); w.z = pk_f16(v1[0], v1[1]); w.w = pk_f16(v1[2], v1[3]);
                    *(u32x4*)(rowp + bj * 128) = w; }
            }
    }
};
struct EpiOut {
    static constexpr bool PERM = true, AFTER_DRAIN = false;
    const float* xold; float* xout; const float* gate;   const float* ng;   const float* scn;   u16* AX; float* part;
    __device__ __forceinline__ void operator()(const pg8::f32x4 (&acc)[2][2][4][2], const pg8::Unit& u, int wr, int wc, int fr, int fq) const {
        const int b = u.pm >> 3, col0 = u.pn * 256 + wc * 32 + 8 * fq;
        f32x4 gv[2][2], Gn[2][2];
#pragma unroll
        for (int bj = 0; bj < 2; ++bj)
#pragma unroll
            for (int n = 0; n < 2; ++n) {
                const int c = col0 + bj * 128 + 4 * n;
                gv[bj][n] = *(const f32x4*)(gate + (size_t)b * 3072 + c);
                if (ng) Gn[bj][n] = *(const f32x4*)(ng + c) * (1.0f + *(const f32x4*)(scn + (size_t)b * 3072 + c)); else Gn[bj][n] = (f32x4){0.f, 0.f, 0.f, 0.f};
            }
#pragma unroll
        for (int ai = 0; ai < 2; ++ai)
#pragma unroll
            for (int m = 0; m < 4; ++m) {
                const int r = u.pm * 256 + ai * 128 + wr * 64 + m * 16 + fr; float ss = 0.f;
#pragma unroll
                for (int bj = 0; bj < 2; ++bj) {
                    const size_t off = (size_t)r * D + col0 + bj * 128;
                    const f32x4 x0 = *(const f32x4*)(xold + off), x1 = *(const f32x4*)(xold + off + 4);
                    const f32x4 n0 = x0 + gv[bj][0] * acc[ai][bj][m][0], n1 = x1 + gv[bj][1] * acc[ai][bj][m][1];
                    *(f32x4*)(xout + off) = n0; *(f32x4*)(xout + off + 4) = n1;
                    ss += (n0[0] * n0[0] + n0[1] * n0[1]) + (n0[2] * n0[2] + n0[3] * n0[3]) + (n1[0] * n1[0] + n1[1] * n1[1]) + (n1[2] * n1[2] + n1[3] * n1[3]);
                    if (ng) { const f32x4 a0 = n0 * Gn[bj][0], a1 = n1 * Gn[bj][1];
                        u32x4 w; w.x = pk_f16(a0[0], a0[1]); w.y = pk_f16(a0[2], a0[3]); w.z = pk_f16(a1[0], a1[1]); w.w = pk_f16(a1[2], a1[3]);
                        *(u32x4*)(AX + off) = w; }
                }
                ss += __shfl_xor(ss, 16); ss += __shfl_xor(ss, 32);
                if (ng && fq == 0) part[(size_t)r * 16 + u.pn * 4 + wc] = ss;
            }
    }
};

struct Frame {
    LAS unsigned char* lds; int tid, lane, wave, G, bid;
};

template <int MODE>
__device__ __forceinline__ void gemv8_item(Frame& F, const LAS float* vec, const float* W, int ldw, int n0, const float* bias, float* outp, int ldo) {
    LAS float* red = (LAS float*)(F.lds + 65536);
    const int n = n0 + F.lane; int src = n; bool valid = true;
    if (MODE == 1) { if (n < DSH) src = n; else if (n < PC_Q) { valid = false; src = 0; } else src = n - 128; }
    float acc[8];
#pragma unroll
    for (int b = 0; b < 8; ++b) acc[b] = 0.f;
    const float* wp = W + (size_t)(F.wave * 128) * ldw + src;
#pragma unroll 8
    for (int k = 0; k < 128; ++k) {
        const float wv = valid ? wp[(size_t)k * ldw] : 0.f;
#pragma unroll
        for (int b = 0; b < 8; ++b) acc[b] += vec[b * 1024 + F.wave * 128 + k] * wv;
    }
#pragma unroll
    for (int b = 0; b < 8; ++b) red[(F.wave * 8 + b) * 64 + F.lane] = acc[b];
    __syncthreads();
    { const int b = F.tid >> 6, ln = F.tid & 63; float s = 0.f;
#pragma unroll
      for (int w = 0; w < 8; ++w) s += red[(w * 8 + b) * 64 + ln];
      const int nn = n0 + ln;
      outp[(size_t)b * ldo + nn] = s + (bias ? bias[nn] : 0.f); }
    __syncthreads();
}

__device__ __forceinline__ void p0a_mod(Frame& F, const Params& p) {
    LAS float* vec = (LAS float*)F.lds;
    for (int i = F.tid; i < 8 * 1024; i += NTHR) { const float v = p.c[i]; vec[i] = v * sigmoidf_(v); }
    __syncthreads();
    float* MOD = (float*)(p.ws + WS_MOD);
    for (int it = F.bid; it < NL * 48; it += F.G) { const int l = it / 48, nb = it % 48;
        gemv8_item<0>(F, vec, p.w_ada + (size_t)l * D * 3072, 3072, nb * 64, p.b_ada + l * 3072, MOD + (size_t)l * 8 * 3072, 3072); }
}

__device__ __forceinline__ void p0_transpose_item(const float* W, int K, int N, int ncol0_src, bool valid, u16* WT, int dst_row0, int k0, LAS float* scr, int lane) {
#pragma unroll 8
    for (int i = 0; i < 32; ++i) { const int kk = 2 * i + (lane >> 5); scr[kk * 33 + (lane & 31)] = valid ? W[(size_t)(k0 + kk) * N + ncol0_src + (lane & 31)] : 0.f; }
    asm volatile("s_waitcnt lgkmcnt(0)" ::: "memory");
    const int cc = lane & 7;
#pragma unroll
    for (int j = 0; j < 4; ++j) { const int n = (lane >> 3) + 8 * j; const LAS float* s = scr + (8 * cc) * 33 + n;
        u32x4 o; o.x = pk_f16(s[0 * 33], s[1 * 33]); o.y = pk_f16(s[2 * 33], s[3 * 33]); o.z = pk_f16(s[4 * 33], s[5 * 33]); o.w = pk_f16(s[6 * 33], s[7 * 33]);
        *(u32x4*)(WT + (size_t)(dst_row0 + n) * K + k0 + 8 * cc) = o; }
    asm volatile("s_waitcnt lgkmcnt(0)" ::: "memory");
}

__device__ __forceinline__ void p0b(Frame& F, const Params& p) {
    const float* MOD = (const float*)(p.ws + WS_MOD);
    u16* WINT = (u16*)(p.ws + WS_WINT); u16* WOUTT = (u16*)(p.ws + WS_WOUTT);
    { LAS float* scr = (LAS float*)(F.lds + F.wave * 16384);
      const int gw = F.bid * NWAVES + F.wave, NGW = F.G * NWAVES;
      constexpr int I_IN = 16 * (NP / 32), I_OUT = 16 * (D / 32);
      for (int it = gw; it < NL * (I_IN + I_OUT); it += NGW) {
          const int l = it / (I_IN + I_OUT); int r = it % (I_IN + I_OUT);
          if (r < I_IN) { const int kb = r / (NP / 32), nb = r % (NP / 32), n0 = nb * 32; int src = n0; bool valid = true;
              if (n0 >= DSH && n0 < PC_Q) { valid = false; src = 0; } else if (n0 >= PC_Q) src = n0 - 128;
              p0_transpose_item(p.w_in + (size_t)l * D * DIN, D, DIN, src, valid, WINT + (size_t)l * NP * D, n0, kb * 64, scr, F.lane); }
          else { r -= I_IN; const int kb = r / (D / 32), nb = r % (D / 32);
              p0_transpose_item(p.w_out + (size_t)l * D * D, D, D, nb * 32, true, WOUTT + (size_t)l * D * D, nb * 32, kb * 64, scr, F.lane); }
      }
    }
    __syncthreads();
    { LAS float* vec = (LAS float*)F.lds; float* SW = (float*)(p.ws + WS_SW); int curl = -1;
      for (int it = F.bid; it < NL * (NP / 64); it += F.G) { const int l = it / (NP / 64), nb = it % (NP / 64);
          if (l != curl) { __syncthreads(); for (int i = F.tid; i < 8 * 1024; i += NTHR) vec[i] = MOD[((size_t)l * 8 + (i >> 10)) * 3072 + (i & 1023)]; __syncthreads(); curl = l; }
          gemv8_item<1>(F, vec, p.w_in + (size_t)l * D * DIN, DIN, nb * 64, nullptr, SW + (size_t)l * 8 * NP, NP); }
    }
    { u16* AX = (u16*)(p.ws + WS_AX); float* PART = (float*)(p.ws + WS_PART);
      const int gw = F.bid * NWAVES + F.wave, NGW = F.G * NWAVES;
      for (int r = gw; r < M; r += NGW) { const int b = r >> 11; float ss = 0.f;
#pragma unroll
          for (int j = 0; j < 4; ++j) { const int c = 4 * F.lane + 256 * j;
              const f32x4 xv = *(const f32x4*)(p.x + (size_t)r * D + c);
              const f32x4 g = *(const f32x4*)(p.norm_g + c) * (1.0f + *(const f32x4*)(MOD + (size_t)b * 3072 + 1024 + c));
              ss += (xv[0] * xv[0] + xv[1] * xv[1]) + (xv[2] * xv[2] + xv[3] * xv[3]);
              const f32x4 a = xv * g; u32x2 w; w.x = pk_f16(a[0], a[1]); w.y = pk_f16(a[2], a[3]);
              *(u32x2*)(AX + (size_t)r * D + c) = w; }
          ss = wave_sum(ss);
          if (F.lane < 16) PART[(size_t)r * 16 + F.lane] = (F.lane == 0) ? ss : 0.f; }
    }
}

__device__ __forceinline__ void p1_rstd(Frame& F, const Params& p, const pg8::StaticOrder& So) {
    LAS float* tab = (LAS float*)(F.lds + LDS_RSTD); const float* PART = (const float*)(p.ws + WS_PART);
    pg8::Unit u;
    for (int i = 0; So.next(i, u) && i < 8; ++i) {
        if (F.tid < 256) { const float* pr = PART + (size_t)(u.pm * 256 + F.tid) * 16; float s = 0.f;
#pragma unroll
            for (int j = 0; j < 4; ++j) { const f32x4 v = *(const f32x4*)(pr + 4 * j); s += (v[0] + v[1]) + (v[2] + v[3]); }
            tab[i * 256 + F.tid] = rsqrtf(s * (1.0f / D) + 1e-6f); }
    }
    __syncthreads();
}

__device__ __forceinline__ void rwkv_unit(Frame& F, const Params& p, int l, int b, int h) {
    LAS float* W2s = (LAS float*)F.lds;
    LAS float* A2s = W2s + 4096;
    LAS float* RAW = A2s + 4096;
    LAS float* VEC = RAW + 6144;
    LAS float* BD = VEC + 5120;
    LAS float* YB = BD + 16;
    const u16* PROJ = (const u16*)(p.ws + WS_PROJ); u16* YO = (u16*)(p.ws + WS_YB);
    const float* mu = p.mu + l * DSH;
    for (int i = F.tid; i < 4096; i += NTHR) { const int j = i >> 6, c = i & 63; W2s[i] = p.w2[((size_t)l * 64 + j) * DR + h * 64 + c]; A2s[i] = p.a2[((size_t)l * 64 + j) * DR + h * 64 + c]; }
    const int c = F.tid & 63, tg = F.tid >> 6, ch = h * 64 + c;
    const float w0c = p.w0[l * DR + ch], a0c = p.a0[l * DR + ch], kkc = p.k_k[l * DR + ch], kac = p.k_a[l * DR + ch], rkc = p.r_k[l * DR + ch];
    const float lgc = p.lnx_g[l * DR + ch], lbc = p.lnx_b[l * DR + ch];
    const int si = F.tid >> 3, sq = F.tid & 7;
    float s[8];
#pragma unroll
    for (int j = 0; j < 8; ++j) s[j] = 0.f;
    __syncthreads();
    for (int t0 = 0; t0 < S; t0 += 16) {
        const size_t row0 = (size_t)b * S + t0;
        for (int e = F.tid; e < 16 * 384; e += NTHR) { const int t = e / 384, cq = e % 384, qn = cq >> 6, cc = cq & 63;
            const int col = (qn < 4) ? (qn * 512 + h * 64 + cc) : (PC_WD + (qn - 4) * 64 + cc);
            const float cur = h2f(PROJ[(row0 + t) * NP + col]);
            const float prev = (t0 + t > 0) ? h2f(PROJ[(row0 + t - 1) * NP + col]) : 0.f;
            float v = cur + mu[col] * (prev - cur);
            if (qn == 4) v = tanhf(v);
            RAW[(qn * 16 + t) * 64 + cc] = v; }
        __syncthreads();
#pragma unroll
        for (int tt = 0; tt < 2; ++tt) { const int t = 2 * tg + tt;
            float wpre = w0c, apre = a0c;
            for (int j = 0; j < 64; ++j) { wpre += RAW[(4 * 16 + t) * 64 + j] * W2s[j * 64 + c]; apre += RAW[(5 * 16 + t) * 64 + j] * A2s[j * 64 + c]; }
            const float decay = __expf(-0.6065306597126334f * sigmoidf_(wpre)), alpha = sigmoidf_(apre);
            const float r = RAW[(0 * 16 + t) * 64 + c], k = RAW[(1 * 16 + t) * 64 + c];
            float kk = k * kkc; const float ss = wave_sum(kk * kk); kk = kk / fmaxf(sqrtf(ss), 1e-12f);
            const float k2 = k * (1.f + (alpha - 1.f) * kac);
            const float bd = wave_sum(r * k2 * rkc);
            VEC[(0 * 16 + t) * 64 + c] = decay; VEC[(1 * 16 + t) * 64 + c] = -kk; VEC[(2 * 16 + t) * 64 + c] = kk * alpha; VEC[(3 * 16 + t) * 64 + c] = k2; VEC[(4 * 16 + t) * 64 + c] = r;
            if (c == 0) BD[t] = bd; }
        __syncthreads();
        for (int t = 0; t < 16; ++t) {
            const LAS float* vw = VEC + (0 * 16 + t) * 64 + sq * 8; const LAS float* va = VEC + (1 * 16 + t) * 64 + sq * 8; const LAS float* vb = VEC + (2 * 16 + t) * 64 + sq * 8;
            const LAS float* vk = VEC + (3 * 16 + t) * 64 + sq * 8; const LAS float* vr = VEC + (4 * 16 + t) * 64 + sq * 8;
            float sa = 0.f;
#pragma unroll
            for (int j = 0; j < 8; ++j) sa += s[j] * va[j];
            sa += __shfl_xor(sa, 1); sa += __shfl_xor(sa, 2); sa += __shfl_xor(sa, 4);
            const float vi = RAW[(2 * 16 + t) * 64 + si]; float y = 0.f;
#pragma unroll
            for (int j = 0; j < 8; ++j) { s[j] = s[j] * vw[j] + sa * vb[j] + vi * vk[j]; y += s[j] * vr[j]; }
            y += __shfl_xor(y, 1); y += __shfl_xor(y, 2); y += __shfl_xor(y, 4);
            if (sq == 0) YB[t * 64 + si] = y;
        }
        __syncthreads();
#pragma unroll
        for (int tt = 0; tt < 2; ++tt) { const int t = 2 * tg + tt;
            const float y = YB[t * 64 + c]; const float mean = wave_sum(y) * (1.f / 64.f); const float yc = y - mean;
            const float var = wave_sum(yc * yc) * (1.f / 64.f);
            float yn = yc * rsqrtf(var + 64e-5f) * lgc + lbc;
            yn += BD[t] * RAW[(2 * 16 + t) * 64 + c];
            const float g = RAW[(3 * 16 + t) * 64 + c];
            YO[(row0 + t) * D + ch] = f2h(yn * (g * sigmoidf_(g))); }
        __syncthreads();
    }
}

__device__ __forceinline__ void attn_unit_naive(Frame& F, const Params& p, int l, int b, int h, int n) {
    const u16* PROJ = (const u16*)(p.ws + WS_PROJ); u16* YO = (u16*)(p.ws + WS_YB);
    const float* bias = p.rel_bias + ((size_t)l * NH + h) * NREL;
    const float* qg = p.qg + l * HD; const float* kg = p.kg + l * HD;
    const int tq = n * 64 + F.lane; const size_t rq = (size_t)b * S + tq;
    float q[64], acc[64];
    { float ss = 0.f;
#pragma unroll
      for (int d8 = 0; d8 < 8; ++d8) { const f16x8 v = *(const f16x8*)(PROJ + rq * NP + PC_Q + h * 64 + d8 * 8);
#pragma unroll
          for (int j = 0; j < 8; ++j) { q[d8 * 8 + j] = (float)v[j]; ss += q[d8 * 8 + j] * q[d8 * 8 + j]; } }
      const float rs = rsqrtf(ss * (1.f / 64.f) + 1e-6f) * 0.125f;
#pragma unroll
      for (int d = 0; d < 64; ++d) { q[d] = q[d] * rs * qg[d] * kg[d]; acc[d] = 0.f; } }
    float mx = -INFINITY, lsum = 0.f;
    const int tk0 = (n > 8 ? n - 8 : 0) * 64, tk1 = n * 64 + 64;
    for (int tk = tk0; tk < tk1; ++tk) {
        const size_t rk = (size_t)b * S + tk;
        const u16* kp = PROJ + rk * NP + PC_KA + h * 64; const u16* vp = PROJ + rk * NP + PC_VA + h * 64;
        float kss = 0.f, dot = 0.f;
#pragma unroll
        for (int d8 = 0; d8 < 8; ++d8) { const f16x8 v = *(const f16x8*)(kp + d8 * 8);
#pragma unroll
            for (int j = 0; j < 8; ++j) { const float kv = (float)v[j]; kss += kv * kv; dot += q[d8 * 8 + j] * kv; } }
        int dist = tq - tk; dist = dist < -63 ? -63 : (dist > 128 ? 128 : dist);
        const float sc = dot * rsqrtf(kss * (1.f / 64.f) + 1e-6f) + bias[dist + 63];
        const float mn = fmaxf(mx, sc); const float corr = __expf(mx - mn), pp = __expf(sc - mn);
        lsum = lsum * corr + pp; mx = mn;
#pragma unroll
        for (int d8 = 0; d8 < 8; ++d8) { const f16x8 v = *(const f16x8*)(vp + d8 * 8);
#pragma unroll
            for (int j = 0; j < 8; ++j) acc[d8 * 8 + j] = acc[d8 * 8 + j] * corr + pp * (float)v[j]; }
    }
    const float inv = 1.f / lsum;
#pragma unroll
    for (int d8 = 0; d8 < 8; ++d8) { const f16x8 gvv = *(const f16x8*)(PROJ + rq * NP + PC_GA + h * 64 + d8 * 8); u32x4 w; unsigned pk[4];
#pragma unroll
        for (int j = 0; j < 4; ++j) { const float g0 = (float)gvv[2 * j], g1 = (float)gvv[2 * j + 1];
            pk[j] = pk_f16(acc[d8 * 8 + 2 * j] * inv * (g0 * sigmoidf_(g0)), acc[d8 * 8 + 2 * j + 1] * inv * (g1 * sigmoidf_(g1))); }
        w.x = pk[0]; w.y = pk[1]; w.z = pk[2]; w.w = pk[3];
        *(u32x4*)(YO + rq * D + DR + h * 64 + d8 * 8) = w; }
}

__device__ __forceinline__ void p2_mixer(Frame& F, const Params& p, int l) {
    if (F.bid < 64) { rwkv_unit(F, p, l, F.bid >> 3, F.bid & 7); }
    else { const int nw = (F.G - 64) * NWAVES, gw = (F.bid - 64) * NWAVES + F.wave;
        for (int u = gw; u < NB * NH * 32; u += nw) { const int uu = __builtin_amdgcn_readfirstlane(u); attn_unit_naive(F, p, l, uu >> 8, (uu >> 5) & 7, uu & 31); } }
}

__global__ void __launch_bounds__(NTHR, 2) mk_fwd(Params p) {
    extern __shared__ __attribute__((aligned(16))) unsigned char lds_raw[];
    cg::grid_group grid = cg::this_grid();
    Frame F; F.lds = (LAS unsigned char*)lds_raw; F.tid = threadIdx.x; F.lane = F.tid & 63; F.wave = __builtin_amdgcn_readfirstlane(F.tid >> 6); F.G = gridDim.x; F.bid = blockIdx.x;
    const int lo = p.ph_lo, hi = p.ph_hi;
    int ph = 0;
#define PHASE_BEGIN if (ph >= lo && ph < hi) { { int t_ = threadIdx.x; asm volatile("" : "+v"(t_)); F.tid = t_; F.lane = t_ & 63; F.wave = __builtin_amdgcn_readfirstlane(t_ >> 6); }
#define PHASE_END(last) if (!(last) && ph + 1 < hi) grid.sync(); } ++ph;
    PHASE_BEGIN p0a_mod(F, p); PHASE_END(false)
    PHASE_BEGIN p0b(F, p); PHASE_END(false)
    for (int l = 0; l < NL; ++l) {
        PHASE_BEGIN {
            pg8::Gemm g{(const u16*)(p.ws + WS_AX), (const u16*)(p.ws + WS_WINT) + (size_t)l * NP * D, M, NP, D};
            pg8::StaticOrder So; So.init(M, NP, F.G, F.bid);
            p1_rstd(F, p, So);
            EpiProj E{(u16*)(p.ws + WS_PROJ), (const float*)(p.ws + WS_SW) + (size_t)l * 8 * NP, (const LAS float*)(F.lds + LDS_RSTD)};
            pg8::gemm_phase<EpiProj, pg8::StaticOrder, true, true>(F.lds, g, So, E);
        } PHASE_END(false)
        PHASE_BEGIN p2_mixer(F, p, l); PHASE_END(false)
        PHASE_BEGIN {
            pg8::Gemm g{(const u16*)(p.ws + WS_YB), (const u16*)(p.ws + WS_WOUTT) + (size_t)l * D * D, M, D, D};
            pg8::StaticOrder So; So.init(M, D, F.G, F.bid);
            const float* MOD = (const float*)(p.ws + WS_MOD);
            EpiOut E{l == 0 ? p.x : p.out, p.out, MOD + (size_t)l * 8 * 3072 + 2048, (l + 1 < NL) ? p.norm_g + (l + 1) * D : nullptr, MOD + (size_t)(l + 1 < NL ? l + 1 : l) * 8 * 3072 + 1024, (u16*)(p.ws + WS_AX), (float*)(p.ws + WS_PART)};
            pg8::gemm_phase<EpiOut, pg8::StaticOrder, true, true>(F.lds, g, So, E);
        } PHASE_END(l == NL - 1)
    }
}

extern "C" void kernel_launch(void* const* d_in, const int* in_sizes, int n_in, void* d_out, int out_size, void* d_ws, size_t ws_size, hipStream_t stream) {
    static int grid = 0;
    if (grid == 0) {
        if (n_in != 20 || out_size != M * D || ws_size < WS_END) { fprintf(stderr, "kernel_launch: unexpected sizes n_in %d out %d ws %zu\n", n_in, out_size, ws_size); grid = -1; return; }
        int dev = 0, cus = 0, per_cu = 0;
        hipGetDevice(&dev); hipDeviceGetAttribute(&cus, hipDeviceAttributeMultiprocessorCount, dev);
        if (hipFuncSetAttribute((const void*)mk_fwd, hipFuncAttributeMaxDynamicSharedMemorySize, LDS_BYTES) != hipSuccess) { fprintf(stderr, "kernel_launch: hipFuncSetAttribute failed\n"); grid = -1; return; }
        if (hipOccupancyMaxActiveBlocksPerMultiprocessor(&per_cu, (const void*)mk_fwd, NTHR, LDS_BYTES) != hipSuccess || per_cu < 1) { fprintf(stderr, "kernel_launch: occupancy query says %d\n", per_cu); per_cu = 1; }
        (void)hipGetLastError();
        grid = cus;
    }
    if (grid < 0) return;
    Params p{};
    const float** pp = (const float**)&p;
    for (int i = 0; i < 20; ++i) pp[i] = (const float*)d_in[i];
    p.out = (float*)d_out; p.ws = (unsigned char*)d_ws;
#ifndef MK_N_PHASE_LAUNCHES
    p.ph_lo = 0; p.ph_hi = 2 + 3 * NL;
    void* args[] = {&p};
    hipError_t e = hipLaunchCooperativeKernel((const void*)mk_fwd, dim3(grid), dim3(NTHR), args, LDS_BYTES, stream);
    if (e != hipSuccess) fprintf(stderr, "cooperative launch failed: %s (grid %d)\n", hipGetErrorString(e), grid);
#else
    for (int ph = 0; ph < 2 + 3 * NL; ++ph) { p.ph_lo = ph; p.ph_hi = ph + 1; hipLaunchKernelGGL(mk_fwd, dim3(grid), dim3(NTHR), LDS_BYTES, stream, p); }
#endif
}
```

```cpp
#include <hip/hip_runtime.h>
#include <hip/hip_cooperative_groups.h>
#include <cstdio>
#include <cstdint>
namespace cg = cooperative_groups;
namespace pg8 {
#define PG8_LAS __attribute__((address_space(3)))
typedef unsigned short bf16_t;
typedef short bf16x8 __attribute__((ext_vector_type(8)));
typedef _Float16 f16x8 __attribute__((ext_vector_type(8)));
typedef float f32x4 __attribute__((ext_vector_type(4)));
typedef unsigned u32x4 __attribute__((ext_vector_type(4)));
constexpr int BM = 256, BK = 64, HALF = 128, HTB = HALF * BK * 2  , STAGE_BYTES = 8 * HTB, NXCD = 8, WGM = 8;

__host__ __device__ __forceinline__ int lds_byte(int r, int c) { const int st = (r >> 4) * 2 + (c >> 5), rr = r & 15, cc = c & 31, ob = rr * 64 + cc * 2; return st * 1024 + (ob ^ (((ob >> 9) & 1) << 5)); }
__host__ __device__ __forceinline__ void stage_rc(int b, int& R, int& C) { const int st = b / 1024, sb = b % 1024, swz = sb ^ (((sb >> 9) & 1) << 5); R = (st >> 1) * 16 + swz / 64; C = (st & 1) * 32 + (swz % 64) / 2; }
__host__ __device__ __forceinline__ int perm32(int rho) { const int n = rho >> 4, i = rho & 15; return 8 * (i >> 2) + 4 * n + (i & 3); }

struct Unit { int pm, pn, ord; };
struct Gemm { const bf16_t* A; const bf16_t* Bt; int M, N, K; };

struct StaticOrder {
    int nM, nN, nwg, G, c;
    __host__ __device__ void init(int M, int N, int G_, int c_) { nM = M / BM; nN = N / BM; nwg = nM * nN; G = G_; c = c_; }
    __host__ __device__ bool next(int i, Unit& u) const {
        const long L = (long)i * G + c; if (L >= nwg) return false;
        int wgid = (int)L; { const int q = nwg / NXCD, r = nwg % NXCD, xcd = wgid % NXCD, off = wgid / NXCD; wgid = (xcd < r ? xcd * (q + 1) : r * (q + 1) + (xcd - r) * q) + off; }
        const int nig = WGM * nN, gid = wgid / nig, fm = gid * WGM, gsz = (nM - fm) < WGM ? (nM - fm) : WGM;
        u.pm = fm + ((wgid % nig) % gsz); u.pn = (wgid % nig) / gsz; u.ord = i; return true;
    }
    __device__ __forceinline__ void a_ready(const Unit&) const {}
    __device__ __forceinline__ void done(const Unit&) const {}
};


template <class Epi, class Sched, bool ALIGN_EPI = false, bool SP2 = false>
__device__ __forceinline__ void gemm_phase(PG8_LAS unsigned char* lds, const Gemm g, const Sched& S, const Epi& E) {
    int tid_ = threadIdx.x; asm volatile("" : "+v"(tid_));
    const int tid = tid_, wid = __builtin_amdgcn_readfirstlane(tid >> 6), lane = tid & 63, wr = wid >> 2, wc = wid & 3, fr = lane & 15, fq = lane >> 4;
    const int K = g.K, nt = K / BK;
    unsigned voffA[2], voffB[2];
#pragma unroll
    for (int i = 0; i < 2; ++i) { int R, C; stage_rc(tid * 16 + i * 8192, R, C); const int Rb = Epi::PERM ? ((R & ~31) + perm32(R & 31)) : R;
        voffA[i] = (unsigned)(R * K + C) * 2u; voffB[i] = (unsigned)(Rb * K + C) * 2u; }
    const size_t kstep = (size_t)(BK * 2);
    const size_t hstep = (size_t)HALF * K * 2;
    const size_t tstep = 2 * hstep;
    const unsigned ldsw = (unsigned)wid * 1024u;
    const int aoff = lds_byte(wr * 64 + fr, fq * 8), boff = lds_byte(wc * 32 + fr, fq * 8);
#define PG8_SA(b, h) (((b) * 2 + (h)) * HTB)
#define PG8_SB(b, h) ((4 + (b) * 2 + (h)) * HTB)
#define PG8_STAGE(bufoff, gbase, voff) do { _Pragma("unroll") for (int _i = 0; _i < 2; ++_i) \
        __builtin_amdgcn_global_load_lds((const unsigned*)((const char*)(gbase) + (voff)[_i]), (PG8_LAS unsigned*)(lds + (bufoff) + ldsw + _i * 8192), 16, 0, 0); } while (0)
#define PG8_LDA(dst, b, h) do { _Pragma("unroll") for (int m = 0; m < 4; ++m) _Pragma("unroll") for (int k = 0; k < 2; ++k) dst[m][k] = *(const PG8_LAS f16x8*)(lds + PG8_SA(b, h) + aoff + m * 2048 + k * 1024); } while (0)
#define PG8_LDB(dst, b, h) do { _Pragma("unroll") for (int n = 0; n < 2; ++n) _Pragma("unroll") for (int k = 0; k < 2; ++k) dst[n][k] = *(const PG8_LAS f16x8*)(lds + PG8_SB(b, h) + boff + n * 2048 + k * 1024); } while (0)
#define PG8_MMA(ai, bj, At, Bt) do { __builtin_amdgcn_s_setprio(1); _Pragma("unroll") for (int m = 0; m < 4; ++m) _Pragma("unroll") for (int n = 0; n < 2; ++n) _Pragma("unroll") for (int k = 0; k < 2; ++k) \
        acc[ai][bj][m][n] = __builtin_amdgcn_mfma_f32_16x16x32_f16(Bt[n][k], At[m][k], acc[ai][bj][m][n], 0, 0, 0); __builtin_amdgcn_s_setprio(0); } while (0)
#define PG8_WAIT_V(n) asm volatile("s_waitcnt vmcnt(" #n ")" ::: "memory")
#define PG8_WAIT_L(n) asm volatile("s_waitcnt lgkmcnt(" #n ")" ::: "memory")
#define PG8_BAR __builtin_amdgcn_s_barrier()
#define PG8_SCHED __builtin_amdgcn_sched_barrier(0)
    Unit cur, nxt; int ui = 0;
    if (!S.next(0, cur)) return;
    f32x4 acc[2][2][4][2];
#pragma unroll
    for (int a = 0; a < 2; ++a)
#pragma unroll
        for (int b = 0; b < 2; ++b)
#pragma unroll
            for (int m = 0; m < 4; ++m)
#pragma unroll
                for (int n = 0; n < 2; ++n) acc[a][b][m][n] = (f32x4){0.f, 0.f, 0.f, 0.f};
    f16x8 At[4][2], B0[2][2], B1[2][2];
    const char* cA = (const char*)g.A + (size_t)cur.pm * tstep; const char* cB = (const char*)g.Bt + (size_t)cur.pn * tstep;
    S.a_ready(cur);
    if constexpr (SP2) {
        PG8_STAGE(PG8_SB(0, 0), cB, voffB); PG8_STAGE(PG8_SB(0, 1), cB + hstep, voffB); PG8_STAGE(PG8_SA(0, 0), cA, voffA); PG8_STAGE(PG8_SA(0, 1), cA + hstep, voffA);
        if (wr == 1) PG8_BAR;
        PG8_WAIT_V(2); PG8_BAR;
        PG8_STAGE(PG8_SB(1, 0), cB + kstep, voffB); PG8_STAGE(PG8_SA(1, 0), cA + kstep, voffA); PG8_STAGE(PG8_SB(1, 1), cB + hstep + kstep, voffB);
        PG8_WAIT_V(6); PG8_BAR;
    } else {
        PG8_STAGE(PG8_SB(0, 0), cB, voffB); PG8_STAGE(PG8_SA(0, 0), cA, voffA); PG8_STAGE(PG8_SB(0, 1), cB + hstep, voffB); PG8_STAGE(PG8_SA(0, 1), cA + hstep, voffA);
        if (wr == 1) PG8_BAR;
        PG8_WAIT_V(4); PG8_BAR;
        PG8_STAGE(PG8_SB(1, 0), cB + kstep, voffB); PG8_STAGE(PG8_SA(1, 0), cA + kstep, voffA); PG8_STAGE(PG8_SB(1, 1), cB + hstep + kstep, voffB);
        PG8_WAIT_V(6); PG8_BAR;
    }
    for (;;) {
        const bool has_next = S.next(ui + 1, nxt);
        const char* nA = has_next ? (const char*)g.A + (size_t)nxt.pm * tstep : cA; const char* nB = has_next ? (const char*)g.Bt + (size_t)nxt.pn * tstep : cB;
        for (int t = 0; t < nt; t += 2) {
            const bool last = (t == nt - 2);
            const char* a1 = cA + (size_t)(t + 1) * kstep;
            const char* a2 = last ? nA : cA + (size_t)(t + 2) * kstep; const char* b2 = last ? nB : cB + (size_t)(t + 2) * kstep;
            const char* a3 = a2 + kstep; const char* b3 = b2 + kstep;
            if (last && has_next) S.a_ready(nxt);
            if constexpr (SP2) {
            PG8_LDB(B0, 0, 0); PG8_LDB(B1, 0, 1); PG8_SCHED; PG8_LDA(At, 0, 0); PG8_STAGE(PG8_SA(1, 1), a1 + hstep, voffA);
            PG8_WAIT_V(8); PG8_WAIT_L(0); PG8_BAR; PG8_MMA(0, 0, At, B0); PG8_MMA(0, 1, At, B1); PG8_BAR; PG8_SCHED;
            PG8_LDA(At, 0, 1); PG8_STAGE(PG8_SB(0, 0), b2, voffB); PG8_STAGE(PG8_SB(0, 1), b2 + hstep, voffB); PG8_STAGE(PG8_SA(0, 0), a2, voffA);
            PG8_WAIT_V(8); PG8_WAIT_L(0); PG8_BAR; PG8_MMA(1, 0, At, B0); PG8_MMA(1, 1, At, B1); PG8_BAR; PG8_SCHED;
            PG8_LDB(B0, 1, 0); PG8_LDB(B1, 1, 1); PG8_SCHED; PG8_LDA(At, 1, 0); PG8_STAGE(PG8_SA(0, 1), a2 + hstep, voffA);
            PG8_WAIT_V(8); PG8_WAIT_L(0); PG8_BAR; PG8_MMA(0, 0, At, B0); PG8_MMA(0, 1, At, B1); PG8_BAR; PG8_SCHED;
            PG8_LDA(At, 1, 1); PG8_STAGE(PG8_SB(1, 0), b3, voffB); PG8_STAGE(PG8_SB(1, 1), b3 + hstep, voffB); PG8_STAGE(PG8_SA(1, 0), a3, voffA);
            PG8_WAIT_V(8); PG8_WAIT_L(0); PG8_BAR; PG8_MMA(1, 0, At, B0); PG8_MMA(1, 1, At, B1); PG8_BAR; PG8_SCHED;
            } else {
            PG8_LDB(B0, 0, 0); PG8_SCHED; PG8_LDA(At, 0, 0); PG8_STAGE(PG8_SA(1, 1), a1 + hstep, voffA);
            PG8_WAIT_L(8); PG8_BAR; PG8_WAIT_L(0); PG8_MMA(0, 0, At, B0); PG8_BAR; PG8_SCHED;
            PG8_LDB(B1, 0, 1); PG8_STAGE(PG8_SB(0, 0), b2, voffB);
            PG8_BAR; PG8_WAIT_L(0); PG8_MMA(0, 1, At, B1); PG8_BAR;
            PG8_LDA(At, 0, 1); PG8_STAGE(PG8_SA(0, 0), a2, voffA);
            PG8_BAR; PG8_WAIT_L(0); PG8_MMA(1, 0, At, B0); PG8_BAR; PG8_SCHED;
            PG8_STAGE(PG8_SB(0, 1), b2 + hstep, voffB);
            PG8_WAIT_V(6); PG8_BAR; PG8_MMA(1, 1, At, B1); PG8_BAR;
            PG8_LDB(B0, 1, 0); PG8_SCHED; PG8_LDA(At, 1, 0); PG8_STAGE(PG8_SA(0, 1), a2 + hstep, voffA);
            PG8_WAIT_L(8); PG8_BAR; PG8_WAIT_L(0); PG8_MMA(0, 0, At, B0); PG8_BAR; PG8_SCHED;
            PG8_LDB(B1, 1, 1); PG8_STAGE(PG8_SB(1, 0), b3, voffB);
            PG8_BAR; PG8_WAIT_L(0); PG8_MMA(0, 1, At, B1); PG8_BAR;
            PG8_LDA(At, 1, 1); PG8_STAGE(PG8_SA(1, 0), a3, voffA);
            PG8_BAR; PG8_WAIT_L(0); PG8_MMA(1, 0, At, B0); PG8_BAR; PG8_SCHED;
            PG8_STAGE(PG8_SB(1, 1), b3 + hstep, voffB);
            PG8_WAIT_V(6); PG8_BAR; PG8_MMA(1, 1, At, B1); PG8_BAR;
            }
        }
        if constexpr (ALIGN_EPI) { if (wr == 0) PG8_BAR; }
        if constexpr (!Epi::AFTER_DRAIN) { E(acc, cur, wr, wc, fr, fq); S.done(cur); }
        if (!has_next) break;
#pragma unroll
        for (int a = 0; a < 2; ++a)
#pragma unroll
            for (int b = 0; b < 2; ++b)
#pragma unroll
                for (int m = 0; m < 4; ++m)
#pragma unroll
                    for (int n = 0; n < 2; ++n) acc[a][b][m][n] = (f32x4){0.f, 0.f, 0.f, 0.f};
        cur = nxt; cA = nA; cB = nB; ++ui;
        if constexpr (ALIGN_EPI) { if (wr == 1) PG8_BAR; }
    }
    PG8_WAIT_V(0);
    if constexpr (!ALIGN_EPI) { if (wr == 0) PG8_BAR; }
    PG8_BAR;
    if constexpr (Epi::AFTER_DRAIN) { E.fused(acc, cur, wr, wc, fr, fq, lds, wid, lane); S.done(cur); }
#undef PG8_SA
#undef PG8_SB
#undef PG8_STAGE
#undef PG8_LDA
#undef PG8_LDB
#undef PG8_MMA
#undef PG8_WAIT_V
#undef PG8_WAIT_L
#undef PG8_BAR
#undef PG8_SCHED
}
}


constexpr int D = 1024, NB = 8, S = 2048, NL = 4, M = NB * S;
constexpr int DIN = 4224, DSH = 2176, DR = 512, NH = 8, HD = 64, NREL = 192;
constexpr int NP = 4352;
constexpr int PC_R = 0, PC_K = 512, PC_V = 1024, PC_G = 1536, PC_WD = 2048, PC_AD = 2112, PC_Q = 2304, PC_KA = 2816, PC_VA = 3328, PC_GA = 3840;
constexpr int NWAVES = 8, NTHR = 512;
constexpr size_t MiB = 1u << 20;
constexpr size_t WS_W2T = 1 * MiB + 512 * 1024, WS_A2T = 1 * MiB + 768 * 1024;
constexpr size_t WS_CTL = 0, WS_MOD = 1 * MiB, WS_SW = 2 * MiB, WS_PART = 3 * MiB, WS_WINT = 4 * MiB, WS_WOUTT = 38 * MiB, WS_AX = 46 * MiB, WS_YB = 78 * MiB, WS_PROJ = 110 * MiB, WS_END = 246 * MiB;
constexpr int LDS_BYTES = 147456;
constexpr int LDS_RSTD = 131072;

#define GAS __attribute__((address_space(1)))
#define LAS __attribute__((address_space(3)))
typedef unsigned short u16;
typedef float f32x4 __attribute__((ext_vector_type(4)));
typedef float f32x2 __attribute__((ext_vector_type(2)));
typedef unsigned u32x4 __attribute__((ext_vector_type(4)));
typedef unsigned u32x2 __attribute__((ext_vector_type(2)));
typedef _Float16 f16x2 __attribute__((ext_vector_type(2)));
typedef _Float16 f16x4 __attribute__((ext_vector_type(4)));
typedef _Float16 f16x8 __attribute__((ext_vector_type(8)));

__device__ __forceinline__ unsigned pk_f16(float lo, float hi) { f32x2 v = {lo, hi}; f16x2 h = __builtin_convertvector(v, f16x2); return __builtin_bit_cast(unsigned, h); }
__device__ __forceinline__ float h2f(u16 h) { return (float)__builtin_bit_cast(_Float16, h); }
__device__ __forceinline__ u16 f2h(float f) { return __builtin_bit_cast(u16, (_Float16)f); }
__device__ __forceinline__ float wave_sum(float v) {
#pragma unroll
    for (int o = 1; o < 64; o <<= 1) v += __shfl_xor(v, o);
    return v;
}
__device__ __forceinline__ float sigmoidf_(float x) { return 1.f / (1.f + __expf(-x)); }

struct Params {
    const float *x, *c, *norm_g, *w_ada, *b_ada, *w_in, *mu, *w0, *w2, *a0, *a2, *k_k, *k_a, *r_k, *lnx_g, *lnx_b, *qg, *kg, *rel_bias, *w_out;
    float* out; unsigned char* ws; int ph_lo, ph_hi;
};

struct EpiProj {
    static constexpr bool PERM = true, AFTER_DRAIN = false;
    u16* O; const float* sw; const LAS float* rstd;
    __device__ __forceinline__ void operator()(const pg8::f32x4 (&acc)[2][2][4][2], const pg8::Unit& u, int wr, int wc, int fr, int fq) const {
        const int b = u.pm >> 3, col0 = u.pn * 256 + wc * 32 + 8 * fq;
        f32x4 sv[2][2];
#pragma unroll
        for (int bj = 0; bj < 2; ++bj)
#pragma unroll
            for (int n = 0; n < 2; ++n) sv[bj][n] = *(const f32x4*)(sw + (size_t)b * NP + col0 + bj * 128 + 4 * n);
#pragma unroll
        for (int ai = 0; ai < 2; ++ai)
#pragma unroll
            for (int m = 0; m < 4; ++m) {
                const int rl = ai * 128 + wr * 64 + m * 16 + fr; const float rs = rstd[u.ord * 256 + rl];
                u16* rowp = O + (size_t)(u.pm * 256 + rl) * NP + col0;
#pragma unroll
                for (int bj = 0; bj < 2; ++bj) {
                    const f32x4 v0 = acc[ai][bj][m][0] * rs + sv[bj][0], v1 = acc[ai][bj][m][1] * rs + sv[bj][1];
                    u32x4 w; w.x = pk_f16(v0[0], v0[1]); w.y = pk_f16(v0[2], v0[3]); w.z = pk_f16(v1[0], v1[1]); w.w = pk_f16(v1[2], v1[3]);
                    *(u32x4*)(rowp + bj * 128) = w; }
            }
    }
};
struct EpiOut {
    static constexpr bool PERM = true, AFTER_DRAIN = false;
    const float* xold; float* xout; const float* gate;   const float* ng;   const float* scn;   u16* AX; float* part;
    __device__ __forceinline__ void operator()(const pg8::f32x4 (&acc)[2][2][4][2], const pg8::Unit& u, int wr, int wc, int fr, int fq) const {
        const int b = u.pm >> 3, col0 = u.pn * 256 + wc * 32 + 8 * fq;
        f32x4 gv[2][2], Gn[2][2];
#pragma unroll
        for (int bj = 0; bj < 2; ++bj)
#pragma unroll
            for (int n = 0; n < 2; ++n) {
                const int c = col0 + bj * 128 + 4 * n;
                gv[bj][n] = *(const f32x4*)(gate + (size_t)b * 3072 + c);
                if (ng) Gn[bj][n] = *(const f32x4*)(ng + c) * (1.0f + *(const f32x4*)(scn + (size_t)b * 3072 + c)); else Gn[bj][n] = (f32x4){0.f, 0.f, 0.f, 0.f};
            }
#pragma unroll
        for (int ai = 0; ai < 2; ++ai)
#pragma unroll
            for (int m = 0; m < 4; ++m) {
                const int r = u.pm * 256 + ai * 128 + wr * 64 + m * 16 + fr; float ss = 0.f;
#pragma unroll
                for (int bj = 0; bj < 2; ++bj) {
                    const size_t off = (size_t)r * D + col0 + bj * 128;
                    const f32x4 x0 = *(const f32x4*)(xold + off), x1 = *(const f32x4*)(xold + off + 4);
                    const f32x4 n0 = x0 + gv[bj][0] * acc[ai][bj][m][0], n1 = x1 + gv[bj][1] * acc[ai][bj][m][1];
                    *(f32x4*)(xout + off) = n0; *(f32x4*)(xout + off + 4) = n1;
                    ss += (n0[0] * n0[0] + n0[1] * n0[1]) + (n0[2] * n0[2] + n0[3] * n0[3]) + (n1[0] * n1[0] + n1[1] * n1[1]) + (n1[2] * n1[2] + n1[3] * n1[3]);
                    if (ng) { const f32x4 a0 = n0 * Gn[bj][0], a1 = n1 * Gn[bj][1];
                        u32x4 w; w.x = pk_f16(a0[0], a0[1]); w.y = pk_f16(a0[2], a0[3]); w.z = pk_f16(a1[0], a1[1]); w.w = pk_f16(a1[2], a1[3]);
                        *(u32x4*)(AX + off) = w; }
                }
                ss += __shfl_xor(ss, 16); ss += __shfl_xor(ss, 32);
                if (ng && fq == 0) part[(size_t)r * 16 + u.pn * 4 + wc] = ss;
            }
    }
};

struct Frame {
    LAS unsigned char* lds; int tid, lane, wave, G, bid;
};

template <int MODE>
__device__ __forceinline__ void gemv8_item(Frame& F, const LAS float* vec, const float* W, int ldw, int n0, const float* bias, float* outp, int ldo) {
    LAS float* red = (LAS float*)(F.lds + 65536);
    const int n = n0 + F.lane; int src = n; bool valid = true;
    if (MODE == 1) { if (n < DSH) src = n; else if (n < PC_Q) { valid = false; src = 0; } else src = n - 128; }
    float acc[8];
#pragma unroll
    for (int b = 0; b < 8; ++b) acc[b] = 0.f;
    const float* wp = W + (size_t)(F.wave * 128) * ldw + src;
#pragma unroll 8
    for (int k = 0; k < 128; ++k) {
        const float wv = valid ? wp[(size_t)k * ldw] : 0.f;
#pragma unroll
        for (int b = 0; b < 8; ++b) acc[b] += vec[b * 1024 + F.wave * 128 + k] * wv;
    }
#pragma unroll
    for (int b = 0; b < 8; ++b) red[(F.wave * 8 + b) * 64 + F.lane] = acc[b];
    __syncthreads();
    { const int b = F.tid >> 6, ln = F.tid & 63; float s = 0.f;
#pragma unroll
      for (int w = 0; w < 8; ++w) s += red[(w * 8 + b) * 64 + ln];
      const int nn = n0 + ln;
      outp[(size_t)b * ldo + nn] = s + (bias ? bias[nn] : 0.f); }
    __syncthreads();
}

__device__ __forceinline__ void p0a_mod(Frame& F, const Params& p) {
    LAS float* vec = (LAS float*)F.lds;
    for (int i = F.tid; i < 8 * 1024; i += NTHR) { const float v = p.c[i]; vec[i] = v * sigmoidf_(v); }
    __syncthreads();
    float* MOD = (float*)(p.ws + WS_MOD);
    for (int it = F.bid; it < NL * 48; it += F.G) { const int l = it / 48, nb = it % 48;
        gemv8_item<0>(F, vec, p.w_ada + (size_t)l * D * 3072, 3072, nb * 64, p.b_ada + l * 3072, MOD + (size_t)l * 8 * 3072, 3072); }
}

__device__ __forceinline__ void p0_transpose_item(const float* W, int K, int N, int ncol0_src, bool valid, u16* WT, int dst_row0, int k0, LAS float* scr, int lane) {
#pragma unroll 8
    for (int i = 0; i < 32; ++i) { const int kk = 2 * i + (lane >> 5); scr[kk * 33 + (lane & 31)] = valid ? W[(size_t)(k0 + kk) * N + ncol0_src + (lane & 31)] : 0.f; }
    asm volatile("s_waitcnt lgkmcnt(0)" ::: "memory");
    const int cc = lane & 7;
#pragma unroll
    for (int j = 0; j < 4; ++j) { const int n = (lane >> 3) + 8 * j; const LAS float* s = scr + (8 * cc) * 33 + n;
        u32x4 o; o.x = pk_f16(s[0 * 33], s[1 * 33]); o.y = pk_f16(s[2 * 33], s[3 * 33]); o.z = pk_f16(s[4 * 33], s[5 * 33]); o.w = pk_f16(s[6 * 33], s[7 * 33]);
        *(u32x4*)(WT + (size_t)(dst_row0 + n) * K + k0 + 8 * cc) = o; }
    asm volatile("s_waitcnt lgkmcnt(0)" ::: "memory");
}

__device__ __forceinline__ void p0b(Frame& F, const Params& p) {
    const float* MOD = (const float*)(p.ws + WS_MOD);
    u16* WINT = (u16*)(p.ws + WS_WINT); u16* WOUTT = (u16*)(p.ws + WS_WOUTT);
    { LAS float* scr = (LAS float*)(F.lds + F.wave * 16384);
      const int gw = F.bid * NWAVES + F.wave, NGW = F.G * NWAVES;
      constexpr int I_IN = 16 * (NP / 32), I_OUT = 16 * (D / 32);
      for (int it = gw; it < NL * (I_IN + I_OUT); it += NGW) {
          const int l = it / (I_IN + I_OUT); int r = it % (I_IN + I_OUT);
          if (r < I_IN) { const int kb = r / (NP / 32), nb = r % (NP / 32), n0 = nb * 32; int src = n0; bool valid = true;
              if (n0 >= DSH && n0 < PC_Q) { valid = false; src = 0; } else if (n0 >= PC_Q) src = n0 - 128;
              p0_transpose_item(p.w_in + (size_t)l * D * DIN, D, DIN, src, valid, WINT + (size_t)l * NP * D, n0, kb * 64, scr, F.lane); }
          else { r -= I_IN; const int kb = r / (D / 32), nb = r % (D / 32);
              p0_transpose_item(p.w_out + (size_t)l * D * D, D, D, nb * 32, true, WOUTT + (size_t)l * D * D, nb * 32, kb * 64, scr, F.lane); }
      }
    }
    __syncthreads();
    { LAS float* vec = (LAS float*)F.lds; float* SW = (float*)(p.ws + WS_SW); int curl = -1;
      for (int it = F.bid; it < NL * (NP / 64); it += F.G) { const int l = it / (NP / 64), nb = it % (NP / 64);
          if (l != curl) { __syncthreads(); for (int i = F.tid; i < 8 * 1024; i += NTHR) vec[i] = MOD[((size_t)l * 8 + (i >> 10)) * 3072 + (i & 1023)]; __syncthreads(); curl = l; }
          gemv8_item<1>(F, vec, p.w_in + (size_t)l * D * DIN, DIN, nb * 64, nullptr, SW + (size_t)l * 8 * NP, NP); }
    }
    { u16* W2T = (u16*)(p.ws + WS_W2T); u16* A2T = (u16*)(p.ws + WS_A2T);
      for (int i = F.bid * NTHR + F.tid; i < NL * DR * 64; i += F.G * NTHR) { const int j = i & 63, c = (i >> 6) & 511, l = i >> 15;
          W2T[i] = f2h(p.w2[((size_t)l * 64 + j) * DR + c]); A2T[i] = f2h(p.a2[((size_t)l * 64 + j) * DR + c]); } }
    { u16* AX = (u16*)(p.ws + WS_AX); float* PART = (float*)(p.ws + WS_PART);
      const int gw = F.bid * NWAVES + F.wave, NGW = F.G * NWAVES;
      for (int r = gw; r < M; r += NGW) { const int b = r >> 11; float ss = 0.f;
#pragma unroll
          for (int j = 0; j < 4; ++j) { const int c = 4 * F.lane + 256 * j;
              const f32x4 xv = *(const f32x4*)(p.x + (size_t)r * D + c);
              const f32x4 g = *(const f32x4*)(p.norm_g + c) * (1.0f + *(const f32x4*)(MOD + (size_t)b * 3072 + 1024 + c));
              ss += (xv[0] * xv[0] + xv[1] * xv[1]) + (xv[2] * xv[2] + xv[3] * xv[3]);
              const f32x4 a = xv * g; u32x2 w; w.x = pk_f16(a[0], a[1]); w.y = pk_f16(a[2], a[3]);
              *(u32x2*)(AX + (size_t)r * D + c) = w; }
          ss = wave_sum(ss);
          if (F.lane < 16) PART[(size_t)r * 16 + F.lane] = (F.lane == 0) ? ss : 0.f; }
    }
}

__device__ __forceinline__ void p1_rstd(Frame& F, const Params& p, const pg8::StaticOrder& So) {
    LAS float* tab = (LAS float*)(F.lds + LDS_RSTD); const float* PART = (const float*)(p.ws + WS_PART);
    pg8::Unit u;
    for (int i = 0; So.next(i, u) && i < 8; ++i) {
        if (F.tid < 256) { const float* pr = PART + (size_t)(u.pm * 256 + F.tid) * 16; float s = 0.f;
#pragma unroll
            for (int j = 0; j < 4; ++j) { const f32x4 v = *(const f32x4*)(pr + 4 * j); s += (v[0] + v[1]) + (v[2] + v[3]); }
            tab[i * 256 + F.tid] = rsqrtf(s * (1.0f / D) + 1e-6f); }
    }
    __syncthreads();
}

__device__ __forceinline__ void rwkv_unit(Frame& F, const Params& p, int l, int b, int h) {
    LAS float* W2s = (LAS float*)F.lds;
    LAS float* A2s = W2s + 4096;
    LAS float* RAW = A2s + 4096;
    LAS float* VEC = RAW + 6144;
    LAS float* BD = VEC + 5120;
    LAS float* YB = BD + 16;
    const u16* PROJ = (const u16*)(p.ws + WS_PROJ); u16* YO = (u16*)(p.ws + WS_YB);
    const float* mu = p.mu + l * DSH;
    for (int i = F.tid; i < 4096; i += NTHR) { const int j = i >> 6, c = i & 63; W2s[i] = p.w2[((size_t)l * 64 + j) * DR + h * 64 + c]; A2s[i] = p.a2[((size_t)l * 64 + j) * DR + h * 64 + c]; }
    const int c = F.tid & 63, tg = F.tid >> 6, ch = h * 64 + c;
    const float w0c = p.w0[l * DR + ch], a0c = p.a0[l * DR + ch], kkc = p.k_k[l * DR + ch], kac = p.k_a[l * DR + ch], rkc = p.r_k[l * DR + ch];
    const float lgc = p.lnx_g[l * DR + ch], lbc = p.lnx_b[l * DR + ch];
    const int si = F.tid >> 3, sq = F.tid & 7;
    float s[8];
#pragma unroll
    for (int j = 0; j < 8; ++j) s[j] = 0.f;
    __syncthreads();
    for (int t0 = 0; t0 < S; t0 += 16) {
        const size_t row0 = (size_t)b * S + t0;
        for (int e = F.tid; e < 16 * 384; e += NTHR) { const int t = e / 384, cq = e % 384, qn = cq >> 6, cc = cq & 63;
            const int col = (qn < 4) ? (qn * 512 + h * 64 + cc) : (PC_WD + (qn - 4) * 64 + cc);
            const float cur = h2f(PROJ[(row0 + t) * NP + col]);
            const float prev = (t0 + t > 0) ? h2f(PROJ[(row0 + t - 1) * NP + col]) : 0.f;
            float v = cur + mu[col] * (prev - cur);
            if (qn == 4) v = tanhf(v);
            RAW[(qn * 16 + t) * 64 + cc] = v; }
        __syncthreads();
#pragma unroll
        for (int tt = 0; tt < 2; ++tt) { const int t = 2 * tg + tt;
            float wpre = w0c, apre = a0c;
            for (int j = 0; j < 64; ++j) { wpre += RAW[(4 * 16 + t) * 64 + j] * W2s[j * 64 + c]; apre += RAW[(5 * 16 + t) * 64 + j] * A2s[j * 64 + c]; }
            const float decay = __expf(-0.6065306597126334f * sigmoidf_(wpre)), alpha = sigmoidf_(apre);
            const float r = RAW[(0 * 16 + t) * 64 + c], k = RAW[(1 * 16 + t) * 64 + c];
            float kk = k * kkc; const float ss = wave_sum(kk * kk); kk = kk / fmaxf(sqrtf(ss), 1e-12f);
            const float k2 = k * (1.f + (alpha - 1.f) * kac);
            const float bd = wave_sum(r * k2 * rkc);
            VEC[(0 * 16 + t) * 64 + c] = decay; VEC[(1 * 16 + t) * 64 + c] = -kk; VEC[(2 * 16 + t) * 64 + c] = kk * alpha; VEC[(3 * 16 + t) * 64 + c] = k2; VEC[(4 * 16 + t) * 64 + c] = r;
            if (c == 0) BD[t] = bd; }
        __syncthreads();
        for (int t = 0; t < 16; ++t) {
            const LAS float* vw = VEC + (0 * 16 + t) * 64 + sq * 8; const LAS float* va = VEC + (1 * 16 + t) * 64 + sq * 8; const LAS float* vb = VEC + (2 * 16 + t) * 64 + sq * 8;
            const LAS float* vk = VEC + (3 * 16 + t) * 64 + sq * 8; const LAS float* vr = VEC + (4 * 16 + t) * 64 + sq * 8;
            float sa = 0.f;
#pragma unroll
            for (int j = 0; j < 8; ++j) sa += s[j] * va[j];
            sa += __shfl_xor(sa, 1); sa += __shfl_xor(sa, 2); sa += __shfl_xor(sa, 4);
            const float vi = RAW[(2 * 16 + t) * 64 + si]; float y = 0.f;
#pragma unroll
            for (int j = 0; j < 8; ++j) { s[j] = s[j] * vw[j] + sa * vb[j] + vi * vk[j]; y += s[j] * vr[j]; }
            y += __shfl_xor(y, 1); y += __shfl_xor(y, 2); y += __shfl_xor(y, 4);
            if (sq == 0) YB[t * 64 + si] = y;
        }
        __syncthreads();
#pragma unroll
        for (int tt = 0; tt < 2; ++tt) { const int t = 2 * tg + tt;
            const float y = YB[t * 64 + c]; const float mean = wave_sum(y) * (1.f / 64.f); const float yc = y - mean;
            const float var = wave_sum(yc * yc) * (1.f / 64.f);
            float yn = yc * rsqrtf(var + 64e-5f) * lgc + lbc;
            yn += BD[t] * RAW[(2 * 16 + t) * 64 + c];
            const float g = RAW[(3 * 16 + t) * 64 + c];
            YO[(row0 + t) * D + ch] = f2h(yn * (g * sigmoidf_(g))); }
        __syncthreads();
    }
}

__device__ __forceinline__ void attn_unit_naive(Frame& F, const Params& p, int l, int b, int h, int n) {
    const u16* PROJ = (const u16*)(p.ws + WS_PROJ); u16* YO = (u16*)(p.ws + WS_YB);
    const float* bias = p.rel_bias + ((size_t)l * NH + h) * NREL;
    const float* qg = p.qg + l * HD; const float* kg = p.kg + l * HD;
    const int tq = n * 64 + F.lane; const size_t rq = (size_t)b * S + tq;
    float q[64], acc[64];
    { float ss = 0.f;
#pragma unroll
      for (int d8 = 0; d8 < 8; ++d8) { const f16x8 v = *(const f16x8*)(PROJ + rq * NP + PC_Q + h * 64 + d8 * 8);
#pragma unroll
          for (int j = 0; j < 8; ++j) { q[d8 * 8 + j] = (float)v[j]; ss += q[d8 * 8 + j] * q[d8 * 8 + j]; } }
      const float rs = rsqrtf(ss * (1.f / 64.f) + 1e-6f) * 0.125f;
#pragma unroll
      for (int d = 0; d < 64; ++d) { q[d] = q[d] * rs * qg[d] * kg[d]; acc[d] = 0.f; } }
    float mx = -INFINITY, lsum = 0.f;
    const int tk0 = (n > 8 ? n - 8 : 0) * 64, tk1 = n * 64 + 64;
    for (int tk = tk0; tk < tk1; ++tk) {
        const size_t rk = (size_t)b * S + tk;
        const u16* kp = PROJ + rk * NP + PC_KA + h * 64; const u16* vp = PROJ + rk * NP + PC_VA + h * 64;
        float kss = 0.f, dot = 0.f;
#pragma unroll
        for (int d8 = 0; d8 < 8; ++d8) { const f16x8 v = *(const f16x8*)(kp + d8 * 8);
#pragma unroll
            for (int j = 0; j < 8; ++j) { const float kv = (float)v[j]; kss += kv * kv; dot += q[d8 * 8 + j] * kv; } }
        int dist = tq - tk; dist = dist < -63 ? -63 : (dist > 128 ? 128 : dist);
#ifdef FORCE_P1
        const float sc = 0.f * dot * kss;
#else
        const float sc = dot * rsqrtf(kss * (1.f / 64.f) + 1e-6f) + bias[dist + 63];
#endif
        const float mn = fmaxf(mx, sc); const float corr = __expf(mx - mn), pp = __expf(sc - mn);
        lsum = lsum * corr + pp; mx = mn;
#pragma unroll
        for (int d8 = 0; d8 < 8; ++d8) { const f16x8 v = *(const f16x8*)(vp + d8 * 8);
#pragma unroll
            for (int j = 0; j < 8; ++j) acc[d8 * 8 + j] = acc[d8 * 8 + j] * corr + pp * (float)v[j]; }
    }
    const float inv = 1.f / lsum;
#pragma unroll
    for (int d8 = 0; d8 < 8; ++d8) { const f16x8 gvv = *(const f16x8*)(PROJ + rq * NP + PC_GA + h * 64 + d8 * 8); u32x4 w; unsigned pk[4];
#pragma unroll
        for (int j = 0; j < 4; ++j) {
#ifdef FORCE_G1
            const float g0 = 1.f + 0.f * (float)gvv[2 * j], g1 = g0;
#else
            const float g0 = (float)gvv[2 * j], g1 = (float)gvv[2 * j + 1];
#endif
            pk[j] = pk_f16(acc[d8 * 8 + 2 * j] * inv * (g0 * sigmoidf_(g0)), acc[d8 * 8 + 2 * j + 1] * inv * (g1 * sigmoidf_(g1)));
#ifdef FORCE_O1
            pk[j] = pk_f16(g0, g1);
#endif
#ifdef FORCE_CONST
            pk[j] = pk_f16(0.25f, 0.25f);
#endif
 }
        w.x = pk[0]; w.y = pk[1]; w.z = pk[2]; w.w = pk[3];
        *(u32x4*)(YO + rq * D + DR + h * 64 + d8 * 8) = w; }
}


typedef short s16x4 __attribute__((ext_vector_type(4)));
typedef short bf16x8 __attribute__((ext_vector_type(8)));
typedef float f32x16 __attribute__((ext_vector_type(16)));
typedef __bf16 bf16x2_t __attribute__((ext_vector_type(2)));
__device__ __forceinline__ unsigned pk_bf16(float lo, float hi) { f32x2 v = {lo, hi}; bf16x2_t b = __builtin_convertvector(v, bf16x2_t); return __builtin_bit_cast(unsigned, b); }
__device__ __forceinline__ s16x4 vtr(const LAS unsigned char* p) { return __builtin_bit_cast(s16x4, __builtin_amdgcn_ds_read_tr16_b64_v4i16((LAS s16x4*)p)); }
constexpr float LOG2E = 1.4426950408889634f;
constexpr int AT_K = 0, AT_V = 16384, AT_BIAS = 32768;

__device__ __forceinline__ void attn_wg_unit(Frame& F, const Params& p, int l, int b, int h, int cgi, size_t yoff = WS_YB) {
    const u16* PROJ = (const u16*)(p.ws + WS_PROJ); u16* YO = (u16*)(p.ws + yoff);
    LAS unsigned char* L = F.lds; LAS float* bias2 = (LAS float*)(L + AT_BIAS);
    const int lane = F.lane, w = F.wave, q32 = lane & 31, hh = lane >> 5;
    const int n0 = cgi * 4, c = n0 + (w >> 1), qh = w & 1;
    __syncthreads();
    if (F.tid < NREL) bias2[F.tid] = p.rel_bias[((size_t)l * NH + h) * NREL + F.tid] * LOG2E;
    const int tq = c * 64 + qh * 32 + q32; const size_t rq = (size_t)b * S + tq;
    f16x8 qf[4];
    { float qv[4][8]; float ss = 0.f;
#pragma unroll
      for (int s4 = 0; s4 < 4; ++s4) { const f16x8 v = *(const f16x8*)(PROJ + rq * NP + PC_Q + h * 64 + 16 * s4 + 8 * hh);
#pragma unroll
          for (int j = 0; j < 8; ++j) { qv[s4][j] = (float)v[j]; ss += qv[s4][j] * qv[s4][j]; } }
      ss += __shfl_xor(ss, 32);
      const float rs = rsqrtf(ss * (1.f / 64.f) + 1e-6f) * (0.125f * LOG2E);
#pragma unroll
      for (int s4 = 0; s4 < 4; ++s4) { const f32x4 g0 = *(const f32x4*)(p.qg + l * HD + 16 * s4 + 8 * hh), g1 = *(const f32x4*)(p.qg + l * HD + 16 * s4 + 8 * hh + 4);
          u32x4 wv; wv.x = pk_f16(qv[s4][0] * rs * g0[0], qv[s4][1] * rs * g0[1]); wv.y = pk_f16(qv[s4][2] * rs * g0[2], qv[s4][3] * rs * g0[3]);
          wv.z = pk_f16(qv[s4][4] * rs * g1[0], qv[s4][5] * rs * g1[1]); wv.w = pk_f16(qv[s4][6] * rs * g1[2], qv[s4][7] * rs * g1[3]);
          qf[s4] = __builtin_bit_cast(f16x8, wv); } }
    f32x16 O0, O1;
#pragma unroll
    for (int r = 0; r < 16; ++r) { O0[r] = 0.f; O1[r] = 0.f; }
    float lsum = 0.f;
    const int jlo = (n0 - 8 > 0) ? n0 - 8 : 0, jhi = n0 + 3;
    const int skey = F.tid >> 3, sch = F.tid & 7;
    const u16* kbase = PROJ + ((size_t)b * S + skey) * NP + PC_KA + h * 64 + sch * 8;
    const u16* vbase = PROJ + ((size_t)b * S + skey) * NP + PC_VA + h * 64 + sch * 8;
    const f32x4 kg0 = *(const f32x4*)(p.kg + l * HD + sch * 8), kg1 = *(const f32x4*)(p.kg + l * HD + sch * 8 + 4);
    u32x4 kreg = *(const u32x4*)(kbase + (size_t)jlo * 64 * NP), vreg = *(const u32x4*)(vbase + (size_t)jlo * 64 * NP);
    const int ti = lane & 15, tg16 = (lane >> 4) & 1;
    const int vrow = (4 * hh + (ti >> 2)) * 128, vsw = ((ti >> 3) & 1) << 6, vcol = 32 * tg16 + 8 * (ti & 3);
    for (int j = jlo; j <= jhi; ++j) {
        const int buf = j & 1;
        {
            const f16x8 kv = __builtin_bit_cast(f16x8, kreg); float kf[8]; float ss = 0.f;
#pragma unroll
            for (int e = 0; e < 8; ++e) { kf[e] = (float)kv[e]; ss += kf[e] * kf[e]; }
            ss += __shfl_xor(ss, 1); ss += __shfl_xor(ss, 2); ss += __shfl_xor(ss, 4);
            const float rs = rsqrtf(ss * (1.f / 64.f) + 1e-6f);
            u32x4 kw; kw.x = pk_f16(kf[0] * rs * kg0[0], kf[1] * rs * kg0[1]); kw.y = pk_f16(kf[2] * rs * kg0[2], kf[3] * rs * kg0[3]);
            kw.z = pk_f16(kf[4] * rs * kg1[0], kf[5] * rs * kg1[1]); kw.w = pk_f16(kf[6] * rs * kg1[2], kf[7] * rs * kg1[3]);
            *(LAS u32x4*)(L + AT_K + buf * 8192 + skey * 128 + ((sch ^ (skey & 7)) * 16)) = kw;
            const f16x8 vv = __builtin_bit_cast(f16x8, vreg);
            u32x4 vw; vw.x = pk_bf16((float)vv[0], (float)vv[1]); vw.y = pk_bf16((float)vv[2], (float)vv[3]); vw.z = pk_bf16((float)vv[4], (float)vv[5]); vw.w = pk_bf16((float)vv[6], (float)vv[7]);
            *(LAS u32x4*)(L + AT_V + buf * 8192 + skey * 128 + ((sch * 16) ^ (((skey >> 1) & 1) << 6))) = vw;
        }
        if (j < jhi) { kreg = *(const u32x4*)(kbase + (size_t)(j + 1) * 64 * NP); vreg = *(const u32x4*)(vbase + (size_t)(j + 1) * 64 * NP); }
        __syncthreads();
        if (j >= c - 8 && j <= c) {
            const int dc = c - j;
            f32x16 st[2];
            if (dc >= 3) { const float cb = bias2[NREL - 1];
#pragma unroll
                for (int r = 0; r < 16; ++r) { st[0][r] = cb; st[1][r] = cb; } }
            else {
#pragma unroll
                for (int kb = 0; kb < 2; ++kb)
#pragma unroll
                    for (int r = 0; r < 16; ++r) { const int keyloc = 32 * kb + (r & 3) + 8 * (r >> 2) + 4 * hh; int dist = 64 * dc + (32 * qh + q32) - keyloc; dist = dist > 128 ? 128 : dist; st[kb][r] = bias2[dist + 63]; } }
            const LAS unsigned char* Kb = L + AT_K + buf * 8192;
#pragma unroll
            for (int kb = 0; kb < 2; ++kb)
#pragma unroll
                for (int s4 = 0; s4 < 4; ++s4) { const f16x8 kfr = *(const LAS f16x8*)(Kb + (32 * kb + q32) * 128 + (((2 * s4 + hh) ^ (q32 & 7)) * 16));
                    st[kb] = __builtin_amdgcn_mfma_f32_32x32x16_f16(kfr, qf[s4], st[kb], 0, 0, 0); }
#pragma unroll
            for (int kb = 0; kb < 2; ++kb)
#pragma unroll
                for (int r = 0; r < 16; ++r) { float pv = __builtin_amdgcn_exp2f(st[kb][r]);
#ifdef FORCE_P1
 pv = 1.0f;
#endif
 lsum += pv; st[kb][r] = pv; }
            const LAS unsigned char* Vb = L + AT_V + buf * 8192 + vrow;
#pragma unroll
            for (int s4 = 0; s4 < 4; ++s4) { const int kb = s4 >> 1, r0 = 8 * (s4 & 1);
                u32x4 pw; pw.x = pk_bf16(st[kb][r0 + 0], st[kb][r0 + 1]); pw.y = pk_bf16(st[kb][r0 + 2], st[kb][r0 + 3]); pw.z = pk_bf16(st[kb][r0 + 4], st[kb][r0 + 5]); pw.w = pk_bf16(st[kb][r0 + 6], st[kb][r0 + 7]);
                const bf16x8 pa = __builtin_bit_cast(bf16x8, pw);
#ifdef NO_PV_MFMA
                if (s4 == 0) {
#pragma unroll
                    for (int r = 0; r < 16; ++r) { const int d = (r & 3) + 8 * (r >> 2) + 4 * hh; float a0 = 0.f, a1 = 0.f;
                        for (int key = 0; key < 64; ++key) { const int sw = ((key >> 1) & 1) << 6;
                            const unsigned short v0 = *(const LAS unsigned short*)(L + AT_V + buf * 8192 + key * 128 + ((d * 2) ^ sw)), v1 = *(const LAS unsigned short*)(L + AT_V + buf * 8192 + key * 128 + ((64 + d * 2) ^ sw));
                            a0 += __uint_as_float((unsigned)v0 << 16); a1 += __uint_as_float((unsigned)v1 << 16); }
                        O0[r] += a0; O1[r] += a1; } } }
#elif defined(NO_TR)
                { bf16x8 vf0, vf1;
#pragma unroll
                  for (int jj = 0; jj < 8; ++jj) { const int key = 16 * s4 + 8 * (jj >> 2) + 4 * hh + (jj & 3); const int sw = ((key >> 1) & 1) << 6;
                      vf0[jj] = *(const LAS short*)(L + AT_V + buf * 8192 + key * 128 + ((q32 * 2) ^ sw));
                      vf1[jj] = *(const LAS short*)(L + AT_V + buf * 8192 + key * 128 + ((64 + q32 * 2) ^ sw)); }
                  O0 = __builtin_amdgcn_mfma_f32_32x32x16_bf16(vf0, pa, O0, 0, 0, 0);
                  O1 = __builtin_amdgcn_mfma_f32_32x32x16_bf16(vf1, pa, O1, 0, 0, 0); } }
#else
                { const s16x4 lo = vtr(Vb + s4 * 2048 + ((vcol) ^ vsw)), hi = vtr(Vb + s4 * 2048 + 1024 + ((vcol) ^ vsw));
                  const bf16x8 vf = {lo[0], lo[1], lo[2], lo[3], hi[0], hi[1], hi[2], hi[3]};
                  O0 = __builtin_amdgcn_mfma_f32_32x32x16_bf16(vf, pa, O0, 0, 0, 0); }
                { const s16x4 lo = vtr(Vb + s4 * 2048 + ((64 + vcol) ^ vsw)), hi = vtr(Vb + s4 * 2048 + 1024 + ((64 + vcol) ^ vsw));
                  const bf16x8 vf = {lo[0], lo[1], lo[2], lo[3], hi[0], hi[1], hi[2], hi[3]};
                  O1 = __builtin_amdgcn_mfma_f32_32x32x16_bf16(vf, pa, O1, 0, 0, 0); } }
#endif
        }
    }
    lsum += __shfl_xor(lsum, 32);
    const float inv = 1.f / lsum;
#pragma unroll
    for (int db = 0; db < 2; ++db)
#pragma unroll
        for (int r4 = 0; r4 < 4; ++r4) { const int d0 = 32 * db + 8 * r4 + 4 * hh;
            const f16x4 gq = *(const f16x4*)(PROJ + rq * NP + PC_GA + h * 64 + d0);
            const float g0 = (float)gq[0], g1 = (float)gq[1], g2 = (float)gq[2], g3 = (float)gq[3];
            const float o0 = (db ? O1[4 * r4 + 0] : O0[4 * r4 + 0]) * inv, o1 = (db ? O1[4 * r4 + 1] : O0[4 * r4 + 1]) * inv, o2 = (db ? O1[4 * r4 + 2] : O0[4 * r4 + 2]) * inv, o3 = (db ? O1[4 * r4 + 3] : O0[4 * r4 + 3]) * inv;
            u32x2 ow; ow.x = pk_f16(o0 * g0 * sigmoidf_(g0), o1 * g1 * sigmoidf_(g1)); ow.y = pk_f16(o2 * g2 * sigmoidf_(g2), o3 * g3 * sigmoidf_(g3));
#ifdef FORCE_O1
            ow.x = pk_f16(g0, g1); ow.y = pk_f16(g2, g3);
#endif
#ifdef FORCE_CONST
            ow.x = pk_f16(0.25f, 0.25f); ow.y = ow.x;
#endif
            *(u32x2*)(YO + rq * D + DR + h * 64 + d0) = ow; }
}


typedef _Float16 f16x4_t __attribute__((ext_vector_type(4)));
constexpr int RW_PITCH = 136;
constexpr int RW_W2T = 0, RW_A2T = 9216, RW_SLOT0 = 18432, RW_SLOT = 12800, RW_SCR0 = RW_SLOT0 + 8 * RW_SLOT, RW_SCR = 2176, RW_CONST = RW_SCR0 + 8 * RW_SCR;
constexpr int SL_WT = 0, SL_RH = 2176, SL_BB = 4352, SL_KB = 6528, SL_VV = 8704, SL_MUKT = 10880, SL_ARBT = 11392, SL_ARKT = 11904, SL_GAM = 12416, SL_BD = 12672;
enum { RC_MUR = 0, RC_MUK, RC_MUV, RC_MUG, RC_W0, RC_A0, RC_KK, RC_KA, RC_RK, RC_LG, RC_LB, RC_MUWD, RC_MUAD };
static_assert(RW_CONST + 13 * 256 <= LDS_BYTES, "rwkv LDS map");

__device__ __forceinline__ f32x4 mfma16(f16x4_t a, f16x4_t b, f32x4 c) { return __builtin_amdgcn_mfma_f32_16x16x16f16(a, b, c, 0, 0, 0); }
__device__ __forceinline__ f32x4 mfma32h(f16x8 a, f16x8 b, f32x4 c) { return __builtin_amdgcn_mfma_f32_16x16x32_f16(a, b, c, 0, 0, 0); }
__device__ __forceinline__ f16x4_t cvt4(f32x4 v) { u32x2 w; w.x = pk_f16(v[0], v[1]); w.y = pk_f16(v[2], v[3]); return __builtin_bit_cast(f16x4_t, w); }
__device__ __forceinline__ f16x8 cat8(f16x4_t a, f16x4_t b) { return (f16x8){a[0], a[1], a[2], a[3], b[0], b[1], b[2], b[3]}; }
__device__ __forceinline__ f16x4_t trr4(const LAS unsigned char* p) { return __builtin_bit_cast(f16x4_t, __builtin_amdgcn_ds_read_tr16_b64_v4i16((LAS s16x4*)p)); }
__device__ __forceinline__ f32x4 cf4(f16x4_t v) { return (f32x4){(float)v[0], (float)v[1], (float)v[2], (float)v[3]}; }
__device__ __forceinline__ float frcp(float x) { return __builtin_amdgcn_rcpf(x); }
__device__ __forceinline__ float fsig(float x) { return frcp(1.f + __expf(-x)); }
#define DPP_SHR(x, n, fillbits) __builtin_bit_cast(float, __builtin_amdgcn_update_dpp((int)(fillbits), __builtin_bit_cast(int, (x)), 0x110 + (n), 0xf, 0xf, false))

__device__ __forceinline__ void rwkv_pre(Frame& F, const Params& p, int b, int h, int ch, LAS unsigned char* slot, LAS unsigned char* scr) {
    const u16* PROJ = (const u16*)(p.ws + WS_PROJ);
    const LAS unsigned char* L = F.lds; const LAS float* RC = (const LAS float*)(L + RW_CONST);
    const int lane = F.lane, t = lane & 15, g4 = lane >> 4;
    const size_t row = (size_t)b * S + ch * 16 + t; const bool hasprev = (ch * 16 + t) > 0;
    const u16* pr = PROJ + row * NP;
    float r_[4][4], k_[4][4];
#pragma unroll
    for (int jt = 0; jt < 4; ++jt) { const int cj = 16 * jt + 4 * g4, col = h * 64 + cj;
        const f32x4 rc = cf4(*(const f16x4_t*)(pr + PC_R + col)), kc = cf4(*(const f16x4_t*)(pr + PC_K + col)), vc = cf4(*(const f16x4_t*)(pr + PC_V + col));
        f32x4 rp = {0.f, 0.f, 0.f, 0.f}, kp = rp, vp = rp;
        if (hasprev) { rp = cf4(*(const f16x4_t*)(pr - NP + PC_R + col)); kp = cf4(*(const f16x4_t*)(pr - NP + PC_K + col)); vp = cf4(*(const f16x4_t*)(pr - NP + PC_V + col)); }
        const f32x4 mr = *(const LAS f32x4*)(RC + RC_MUR * 64 + cj), mk = *(const LAS f32x4*)(RC + RC_MUK * 64 + cj), mv = *(const LAS f32x4*)(RC + RC_MUV * 64 + cj);
        const f32x4 rs = rc + mr * (rp - rc), ks = kc + mk * (kp - kc), vs = vc + mv * (vp - vc);
#pragma unroll
        for (int e = 0; e < 4; ++e) { r_[jt][e] = rs[e]; k_[jt][e] = ks[e]; }
        *(LAS f16x4_t*)(slot + SL_VV + t * RW_PITCH + cj * 2) = cvt4(vs); }
    f16x8 twd[2], adf[2];
#pragma unroll
    for (int ks = 0; ks < 2; ++ks) { const int cj = 32 * ks + 8 * g4;
        const f16x8 wc = *(const f16x8*)(pr + PC_WD + cj), ac = *(const f16x8*)(pr + PC_AD + cj);
        f16x8 wp, ap;
#pragma unroll
        for (int e = 0; e < 8; ++e) { wp[e] = (_Float16)0.f; ap[e] = (_Float16)0.f; }
        if (hasprev) { wp = *(const f16x8*)(pr - NP + PC_WD + cj); ap = *(const f16x8*)(pr - NP + PC_AD + cj); }
        float wv[8], av[8];
#pragma unroll
        for (int hf = 0; hf < 2; ++hf) { const f32x4 mw = *(const LAS f32x4*)(RC + RC_MUWD * 64 + cj + 4 * hf), ma = *(const LAS f32x4*)(RC + RC_MUAD * 64 + cj + 4 * hf);
#pragma unroll
            for (int e = 0; e < 4; ++e) { const int q = 4 * hf + e; const float wcur = (float)wc[q], acur = (float)ac[q];
                const float ws_ = wcur + mw[e] * ((float)wp[q] - wcur); av[q] = acur + ma[e] * ((float)ap[q] - acur);
                const float ex = __expf(2.f * ws_); wv[q] = 1.f - 2.f * frcp(ex + 1.f); } }
        u32x4 tw, aw; tw.x = pk_f16(wv[0], wv[1]); tw.y = pk_f16(wv[2], wv[3]); tw.z = pk_f16(wv[4], wv[5]); tw.w = pk_f16(wv[6], wv[7]);
        aw.x = pk_f16(av[0], av[1]); aw.y = pk_f16(av[2], av[3]); aw.z = pk_f16(av[4], av[5]); aw.w = pk_f16(av[6], av[7]);
        twd[ks] = __builtin_bit_cast(f16x8, tw); adf[ks] = __builtin_bit_cast(f16x8, aw); }
    float lw_[4][4], al_[4][4];
#pragma unroll
    for (int ct = 0; ct < 4; ++ct) { f32x4 aw = {0.f, 0.f, 0.f, 0.f}, aa = aw;
#pragma unroll
        for (int ks = 0; ks < 2; ++ks) { const int off = (16 * ct + t) * 144 + (32 * ks + 8 * g4) * 2;
            aw = mfma32h(*(const LAS f16x8*)(L + RW_W2T + off), twd[ks], aw); aa = mfma32h(*(const LAS f16x8*)(L + RW_A2T + off), adf[ks], aa); }
        const int cj = 16 * ct + 4 * g4;
        const f32x4 w0v = *(const LAS f32x4*)(RC + RC_W0 * 64 + cj), a0v = *(const LAS f32x4*)(RC + RC_A0 * 64 + cj);
#pragma unroll
        for (int e = 0; e < 4; ++e) { lw_[ct][e] = -0.6065306597126334f * fsig(w0v[e] + aw[e]); al_[ct][e] = fsig(a0v[e] + aa[e]); } }
    float kk_[4][4], k2_[4][4]; float ss = 0.f, bd = 0.f;
#pragma unroll
    for (int jt = 0; jt < 4; ++jt) { const int cj = 16 * jt + 4 * g4;
        const f32x4 kkv = *(const LAS f32x4*)(RC + RC_KK * 64 + cj), kav = *(const LAS f32x4*)(RC + RC_KA * 64 + cj), rkv = *(const LAS f32x4*)(RC + RC_RK * 64 + cj);
#pragma unroll
        for (int e = 0; e < 4; ++e) { const float kk = k_[jt][e] * kkv[e]; kk_[jt][e] = kk; ss += kk * kk;
            const float k2 = k_[jt][e] * (1.f + (al_[jt][e] - 1.f) * kav[e]); k2_[jt][e] = k2; bd += r_[jt][e] * k2 * rkv[e]; } }
    ss += __shfl_xor(ss, 16); ss += __shfl_xor(ss, 32); bd += __shfl_xor(bd, 16); bd += __shfl_xor(bd, 32);
    const float rn = 1.f / fmaxf(sqrtf(ss), 1e-12f);
    if (g4 == 0) *(LAS float*)(slot + SL_BD + t * 4) = bd;
    f16x4_t Ahp[4], Rhp[4], Bcp[4], Kcp[4];
#pragma unroll
    for (int jt = 0; jt < 4; ++jt) { f32x4 ah, rh, bc, kc, bb, kb, gm;
#pragma unroll
        for (int e = 0; e < 4; ++e) { float G = lw_[jt][e];
            G += DPP_SHR(G, 1, 0); G += DPP_SHR(G, 2, 0); G += DPP_SHR(G, 4, 0); G += DPP_SHR(G, 8, 0);
            const float E1 = __expf(G); const float E0 = DPP_SHR(E1, 1, 0x3f800000); const float Ei = frcp(E1);
            const float gam = __builtin_bit_cast(float, __builtin_amdgcn_ds_bpermute(((lane & 48) | 15) << 2, __builtin_bit_cast(int, E1)));
            const float E2 = gam * Ei; const float a = -kk_[jt][e] * rn, bq = -a * al_[jt][e];
            ah[e] = a * E0; rh[e] = r_[jt][e] * E1; bc[e] = bq * Ei; kc[e] = k2_[jt][e] * Ei; bb[e] = bq * E2; kb[e] = k2_[jt][e] * E2; gm[e] = gam; }
        Ahp[jt] = cvt4(ah); Rhp[jt] = cvt4(rh); Bcp[jt] = cvt4(bc); Kcp[jt] = cvt4(kc);
        const int o = t * RW_PITCH + (16 * jt + 4 * g4) * 2;
        *(LAS f16x4_t*)(scr + o) = Ahp[jt]; *(LAS f16x4_t*)(slot + SL_RH + o) = Rhp[jt]; *(LAS f16x4_t*)(slot + SL_BB + o) = cvt4(bb); *(LAS f16x4_t*)(slot + SL_KB + o) = cvt4(kb);
        if (t == 15) *(LAS f32x4*)(slot + SL_GAM + (16 * jt + 4 * g4) * 4) = gm; }
    const f32x4 Z = {0.f, 0.f, 0.f, 0.f};
    f32x4 Aab = Z, AabT = Z, Aak = Z, ArbT = Z, ArkT = Z;
#pragma unroll
    for (int ks = 0; ks < 2; ++ks) { const f16x8 ah = cat8(Ahp[2 * ks], Ahp[2 * ks + 1]), rh = cat8(Rhp[2 * ks], Rhp[2 * ks + 1]), bc = cat8(Bcp[2 * ks], Bcp[2 * ks + 1]), kc = cat8(Kcp[2 * ks], Kcp[2 * ks + 1]);
        Aab = mfma32h(ah, bc, Aab); AabT = mfma32h(bc, ah, AabT); Aak = mfma32h(ah, kc, Aak); ArbT = mfma32h(bc, rh, ArbT); ArkT = mfma32h(kc, rh, ArkT); }
    f32x4 Q;
#pragma unroll
    for (int rr = 0; rr < 4; ++rr) { const int row4 = 4 * g4 + rr;
        Aab[rr] = (t < row4) ? Aab[rr] : 0.f; Aak[rr] = (t < row4) ? Aak[rr] : 0.f;
        AabT[rr] = (row4 < t) ? AabT[rr] : 0.f;
        ArbT[rr] = (row4 <= t) ? ArbT[rr] : 0.f; ArkT[rr] = (row4 <= t) ? ArkT[rr] : 0.f;
        Q[rr] = AabT[rr] + ((row4 == t) ? 1.f : 0.f); }
    const f16x4_t x = cvt4(Aab), xt = cvt4(AabT);
    const f32x4 A2 = mfma16(xt, x, Z), A2t = mfma16(x, xt, Z);
    const f16x4_t a2 = cvt4(A2), a2t = cvt4(A2t);
    const f32x4 A4 = mfma16(a2t, a2, Z), A4t = mfma16(a2, a2t, Z);
    const f16x4_t a4 = cvt4(A4), a4t = cvt4(A4t);
    const f32x4 A8 = mfma16(a4t, a4, Z);
    Q = mfma16(a2, cvt4(Q), Q); Q = mfma16(a4, cvt4(Q), Q); Q = mfma16(cvt4(A8), cvt4(Q), Q);
    const f16x4_t tt = cvt4(Q);
    const int tro = (4 * g4 + (t >> 2)) * RW_PITCH + 8 * (t & 3);
#pragma unroll
    for (int jt = 0; jt < 4; ++jt) { const f32x4 wt = mfma16(trr4(scr + tro + 32 * jt), tt, Z);
        *(LAS f16x4_t*)(slot + SL_WT + t * RW_PITCH + (16 * jt + 4 * g4) * 2) = cvt4(wt); }
    *(LAS f16x4_t*)(slot + SL_MUKT + lane * 8) = cvt4(mfma16(cvt4(Aak), tt, Z));
    *(LAS f16x4_t*)(slot + SL_ARBT + lane * 8) = cvt4(ArbT);
    *(LAS f16x4_t*)(slot + SL_ARKT + lane * 8) = cvt4(ArkT);
}

__device__ __forceinline__ void rwkv_chain(Frame& F, f32x4 (&st)[4], const LAS unsigned char* slot, LAS unsigned char* ybuf, int it) {
    const int lane = F.lane, t = lane & 15, g4 = lane >> 4;
    const f32x4 Z = {0.f, 0.f, 0.f, 0.f};
    const int tro = (4 * g4 + (t >> 2)) * RW_PITCH + 8 * (t & 3), l1o = t * RW_PITCH + 8 * g4;
    f16x4_t sb[4];
#pragma unroll
    for (int jt = 0; jt < 4; ++jt) sb[jt] = cvt4(st[jt]);
    const f16x4_t vf = trr4(slot + SL_VV + tro + 32 * it);
    f32x4 U = Z;
#pragma unroll
    for (int jt = 0; jt < 4; ++jt) U = mfma16(*(const LAS f16x4_t*)(slot + SL_WT + l1o + 32 * jt), sb[jt], U);
    U = mfma16(*(const LAS f16x4_t*)(slot + SL_MUKT + lane * 8), vf, U);
    const f16x4_t uf = cvt4(U);
    f32x4 Y = Z;
#pragma unroll
    for (int jt = 0; jt < 4; ++jt) Y = mfma16(sb[jt], *(const LAS f16x4_t*)(slot + SL_RH + l1o + 32 * jt), Y);
    Y = mfma16(uf, *(const LAS f16x4_t*)(slot + SL_ARBT + lane * 8), Y);
    Y = mfma16(vf, *(const LAS f16x4_t*)(slot + SL_ARKT + lane * 8), Y);
    *(LAS f16x4_t*)(ybuf + t * RW_PITCH + (16 * it + 4 * g4) * 2) = cvt4(Y);
#pragma unroll
    for (int jt = 0; jt < 4; ++jt) { const f32x4 gm = *(const LAS f32x4*)(slot + SL_GAM + (16 * jt + 4 * g4) * 4);
        f32x4 s2 = st[jt] * gm;
        s2 = mfma16(trr4(slot + SL_BB + tro + 32 * jt), uf, s2);
        s2 = mfma16(trr4(slot + SL_KB + tro + 32 * jt), vf, s2);
        st[jt] = s2; }
}

__device__ __forceinline__ void rwkv_post(Frame& F, const Params& p, int b, int h, int ch, const LAS unsigned char* slot, const LAS unsigned char* ybuf) {
    const u16* PROJ = (const u16*)(p.ws + WS_PROJ); u16* YO = (u16*)(p.ws + WS_YB);
    const LAS float* RC = (const LAS float*)(F.lds + RW_CONST);
    const int lane = F.lane, t = lane & 15, g4 = lane >> 4;
    const size_t row = (size_t)b * S + ch * 16 + t; const bool hasprev = (ch * 16 + t) > 0;
    f32x4 y[4]; float s1 = 0.f;
#pragma unroll
    for (int it = 0; it < 4; ++it) { y[it] = cf4(*(const LAS f16x4_t*)(ybuf + t * RW_PITCH + (16 * it + 4 * g4) * 2)); s1 += (y[it][0] + y[it][1]) + (y[it][2] + y[it][3]); }
    s1 += __shfl_xor(s1, 16); s1 += __shfl_xor(s1, 32);
    const float mean = s1 * (1.f / 64.f); float s2 = 0.f;
#pragma unroll
    for (int it = 0; it < 4; ++it) { y[it] = y[it] - mean; s2 += (y[it][0] * y[it][0] + y[it][1] * y[it][1]) + (y[it][2] * y[it][2] + y[it][3] * y[it][3]); }
    s2 += __shfl_xor(s2, 16); s2 += __shfl_xor(s2, 32);
    const float rstd = rsqrtf(s2 * (1.f / 64.f) + 64e-5f);
    const float bd = *(const LAS float*)(slot + SL_BD + t * 4);
#pragma unroll
    for (int it = 0; it < 4; ++it) { const int ci = 16 * it + 4 * g4, col = h * 64 + ci;
        const f32x4 lg = *(const LAS f32x4*)(RC + RC_LG * 64 + ci), lb = *(const LAS f32x4*)(RC + RC_LB * 64 + ci), mg = *(const LAS f32x4*)(RC + RC_MUG * 64 + ci);
        const f32x4 v = cf4(*(const LAS f16x4_t*)(slot + SL_VV + t * RW_PITCH + ci * 2));
        const f32x4 gc = cf4(*(const f16x4_t*)(PROJ + row * NP + PC_G + col)); f32x4 gp = {0.f, 0.f, 0.f, 0.f};
        if (hasprev) gp = cf4(*(const f16x4_t*)(PROJ + (row - 1) * NP + PC_G + col));
        const f32x4 g = gc + mg * (gp - gc);
        f32x4 o;
#pragma unroll
        for (int e = 0; e < 4; ++e) { const float yn = y[it][e] * rstd * lg[e] + lb[e] + bd * v[e]; o[e] = yn * g[e] * fsig(g[e]); }
        *(f16x4_t*)(YO + row * D + col) = cvt4(o); }
}

__device__ __forceinline__ void rwkv_unit_chunked(Frame& F, const Params& p, int l, int b, int h) {
    LAS unsigned char* L = F.lds;
    { LAS float* RC = (LAS float*)(L + RW_CONST);
      for (int i = F.tid; i < 13 * 64; i += NTHR) { const int a = i >> 6, c = i & 63; float v;
          switch (a) { case RC_MUR: v = p.mu[l * DSH + PC_R + h * 64 + c]; break; case RC_MUK: v = p.mu[l * DSH + PC_K + h * 64 + c]; break; case RC_MUV: v = p.mu[l * DSH + PC_V + h * 64 + c]; break;
              case RC_MUG: v = p.mu[l * DSH + PC_G + h * 64 + c]; break; case RC_W0: v = p.w0[l * DR + h * 64 + c]; break; case RC_A0: v = p.a0[l * DR + h * 64 + c]; break;
              case RC_KK: v = p.k_k[l * DR + h * 64 + c]; break; case RC_KA: v = p.k_a[l * DR + h * 64 + c]; break; case RC_RK: v = p.r_k[l * DR + h * 64 + c]; break;
              case RC_LG: v = p.lnx_g[l * DR + h * 64 + c]; break; case RC_LB: v = p.lnx_b[l * DR + h * 64 + c]; break; case RC_MUWD: v = p.mu[l * DSH + PC_WD + c]; break; default: v = p.mu[l * DSH + PC_AD + c]; break; }
          RC[i] = v; }
      const u16* w2t = (const u16*)(p.ws + WS_W2T) + ((size_t)l * DR + h * 64) * 64; const u16* a2t = (const u16*)(p.ws + WS_A2T) + ((size_t)l * DR + h * 64) * 64;
      { const int c = F.tid >> 3, q = F.tid & 7;
        *(LAS u32x4*)(L + RW_W2T + c * 144 + q * 16) = *(const u32x4*)(w2t + c * 64 + q * 8); *(LAS u32x4*)(L + RW_A2T + c * 144 + q * 16) = *(const u32x4*)(a2t + c * 64 + q * 8); } }
    __syncthreads();
    const int w = F.wave;
    LAS unsigned char* slot = L + RW_SLOT0 + w * RW_SLOT; LAS unsigned char* scr = L + RW_SCR0 + w * RW_SCR;
    f32x4 st[4];
#pragma unroll
    for (int jt = 0; jt < 4; ++jt) st[jt] = (f32x4){0.f, 0.f, 0.f, 0.f};
    for (int sc = 0; sc < S / 128; ++sc) {
        if (sc > 0) rwkv_post(F, p, b, h, (sc - 1) * 8 + w, slot, scr);
        rwkv_pre(F, p, b, h, sc * 8 + w, slot, scr);
        __syncthreads();
        if (w < 4) {
#pragma unroll 1
            for (int cc = 0; cc < 8; ++cc) rwkv_chain(F, st, L + RW_SLOT0 + cc * RW_SLOT, L + RW_SCR0 + cc * RW_SCR, w);
        }
        __syncthreads();
    }
    rwkv_post(F, p, b, h, (S / 128 - 1) * 8 + w, slot, scr);
}

#ifdef ATTN_DEBUG
__device__ __forceinline__ int dbg_class(int chunk) { return chunk == 0 ? 0 : chunk == 1 ? 1 : chunk == 2 ? 2 : chunk == 3 ? 3 : chunk < 8 ? 4 : 5; }
__device__ __forceinline__ void dbg_compare(Frame& F, const Params& p) {
    const u16* A = (const u16*)(p.ws + WS_YB); const u16* Bn = (const u16*)(p.ws + WS_AX); float* ctl = (float*)(p.ws + WS_CTL);
    const int gw = F.bid * NWAVES + F.wave, NGW = F.G * NWAVES;
    for (int r = gw; r < M; r += NGW) { const int chunk = (r & 2047) >> 6; const int cls = dbg_class(chunk);
        float sd = 0.f, sr = 0.f, sb = 0.f;
        for (int c = F.lane; c < 512; c += 64) { const float a = h2f(A[(size_t)r * D + 512 + c]), bq = h2f(Bn[(size_t)r * D + 512 + c]); sd += (a - bq) * (a - bq); sr += a * a; sb += bq * bq; }
        sd = wave_sum(sd); sr = wave_sum(sr); sb = wave_sum(sb);
        if (F.lane == 0) { atomicAdd(ctl + 2 * cls, sd); atomicAdd(ctl + 2 * cls + 1, sr); atomicAdd(ctl + 16 + cls, sb); } }
}
#endif

__device__ __forceinline__ void p2_mixer(Frame& F, const Params& p, int l) {
    if (F.bid < 64) {
#ifdef RWKV_NAIVE
        rwkv_unit(F, p, l, F.bid >> 3, F.bid & 7);
#else
        rwkv_unit_chunked(F, p, l, F.bid >> 3, F.bid & 7);
#endif
    }
    else {
#ifdef ATTN_NAIVE
        const int nw = (F.G - 64) * NWAVES, gw = (F.bid - 64) * NWAVES + F.wave;
        for (int u = gw; u < NB * NH * 32; u += nw) { const int uu = __builtin_amdgcn_readfirstlane(u); attn_unit_naive(F, p, l, uu >> 8, (uu >> 5) & 7, uu & 31); }
#elif defined(ATTN_DEBUG)
        { const int nw = (F.G - 64) * NWAVES, gw = (F.bid - 64) * NWAVES + F.wave;
          for (int u = gw; u < NB * NH * 32; u += nw) { const int uu = __builtin_amdgcn_readfirstlane(u); attn_unit_naive(F, p, l, uu >> 8, (uu >> 5) & 7, uu & 31); } }
        for (int u = F.bid - 64; u < NB * NH * 8; u += F.G - 64) attn_wg_unit(F, p, l, u >> 6, (u >> 3) & 7, u & 7, WS_AX);
#else
        for (int u = F.bid - 64; u < NB * NH * 8; u += F.G - 64) attn_wg_unit(F, p, l, u >> 6, (u >> 3) & 7, u & 7);
#endif
    }
}

__global__ void __launch_bounds__(NTHR, 2) mk_fwd(Params p) {
    extern __shared__ __attribute__((aligned(16))) unsigned char lds_raw[];
    cg::grid_group grid = cg::this_grid();
    Frame F; F.lds = (LAS unsigned char*)lds_raw; F.tid = threadIdx.x; F.lane = F.tid & 63; F.wave = __builtin_amdgcn_readfirstlane(F.tid >> 6); F.G = gridDim.x; F.bid = blockIdx.x;
    const int lo = p.ph_lo, hi = p.ph_hi;
    int ph = 0;
#define PHASE_BEGIN if (ph >= lo && ph < hi) { { int t_ = threadIdx.x; asm volatile("" : "+v"(t_)); F.tid = t_; F.lane = t_ & 63; F.wave = __builtin_amdgcn_readfirstlane(t_ >> 6); }
#define PHASE_END(last) if (!(last) && ph + 1 < hi) grid.sync(); } ++ph;
    PHASE_BEGIN p0a_mod(F, p); PHASE_END(false)
    PHASE_BEGIN p0b(F, p); PHASE_END(false)
    for (int l = 0; l < NL; ++l) {
        PHASE_BEGIN {
            pg8::Gemm g{(const u16*)(p.ws + WS_AX), (const u16*)(p.ws + WS_WINT) + (size_t)l * NP * D, M, NP, D};
            pg8::StaticOrder So; So.init(M, NP, F.G, F.bid);
            p1_rstd(F, p, So);
            EpiProj E{(u16*)(p.ws + WS_PROJ), (const float*)(p.ws + WS_SW) + (size_t)l * 8 * NP, (const LAS float*)(F.lds + LDS_RSTD)};
            pg8::gemm_phase<EpiProj, pg8::StaticOrder, true, true>(F.lds, g, So, E);
        } PHASE_END(false)
        PHASE_BEGIN p2_mixer(F, p, l); PHASE_END(false)
#ifdef ATTN_DEBUG
        if (l == 0) { dbg_compare(F, p); grid.sync(); }
#endif
        PHASE_BEGIN {
            pg8::Gemm g{(const u16*)(p.ws + WS_YB), (const u16*)(p.ws + WS_WOUTT) + (size_t)l * D * D, M, D, D};
            pg8::StaticOrder So; So.init(M, D, F.G, F.bid);
            const float* MOD = (const float*)(p.ws + WS_MOD);
            EpiOut E{l == 0 ? p.x : p.out, p.out, MOD + (size_t)l * 8 * 3072 + 2048, (l + 1 < NL) ? p.norm_g + (l + 1) * D : nullptr, MOD + (size_t)(l + 1 < NL ? l + 1 : l) * 8 * 3072 + 1024, (u16*)(p.ws + WS_AX), (float*)(p.ws + WS_PART)};
            pg8::gemm_phase<EpiOut, pg8::StaticOrder, true, true>(F.lds, g, So, E);
        } PHASE_END(l == NL - 1)
    }
#ifdef ATTN_DEBUG
    grid.sync();
    if (F.bid == 0 && F.tid == 0) { const float* ctl = (const float*)(p.ws + WS_CTL); float code = 0.f;
        for (int k = 5; k >= 0; --k) { const float ratio = sqrtf(ctl[2 * k] / fmaxf(ctl[2 * k + 1], 1e-30f)); if (ratio > 0.01f) code = 1000.f * (k + 1) + 1000.f * fminf(ratio, 0.95f); }
        p.out[0] += code; }
#endif
}

extern "C" void kernel_launch(void* const* d_in, const int* in_sizes, int n_in, void* d_out, int out_size, void* d_ws, size_t ws_size, hipStream_t stream) {
    static int grid = 0;
    if (grid == 0) {
        if (n_in != 20 || out_size != M * D || ws_size < WS_END) { fprintf(stderr, "kernel_launch: unexpected sizes n_in %d out %d ws %zu\n", n_in, out_size, ws_size); grid = -1; return; }
        int dev = 0, cus = 0, per_cu = 0;
        hipGetDevice(&dev); hipDeviceGetAttribute(&cus, hipDeviceAttributeMultiprocessorCount, dev);
        if (hipFuncSetAttribute((const void*)mk_fwd, hipFuncAttributeMaxDynamicSharedMemorySize, LDS_BYTES) != hipSuccess) { fprintf(stderr, "kernel_launch: hipFuncSetAttribute failed\n"); grid = -1; return; }
        if (hipOccupancyMaxActiveBlocksPerMultiprocessor(&per_cu, (const void*)mk_fwd, NTHR, LDS_BYTES) != hipSuccess || per_cu < 1) { fprintf(stderr, "kernel_launch: occupancy query says %d\n", per_cu); per_cu = 1; }
        (void)hipGetLastError();
        grid = cus;
    }
    if (grid < 0) return;
    Params p{};
#ifdef ATTN_DEBUG
    hipMemsetAsync(d_ws, 0, 4096, stream);
#endif
    const float** pp = (const float**)&p;
    for (int i = 0; i < 20; ++i) pp[i] = (const float*)d_in[i];
    p.out = (float*)d_out; p.ws = (unsigned char*)d_ws;
#ifndef MK_N_PHASE_LAUNCHES
    p.ph_lo = 0; p.ph_hi = 2 + 3 * NL;
    void* args[] = {&p};
    hipError_t e = hipLaunchCooperativeKernel((const void*)mk_fwd, dim3(grid), dim3(NTHR), args, LDS_BYTES, stream);
    if (e != hipSuccess) fprintf(stderr, "cooperative launch failed: %s (grid %d)\n", hipGetErrorString(e), grid);
#else
    for (int ph = 0; ph < 2 + 3 * NL; ++ph) { p.ph_lo = ph; p.ph_hi = ph + 1; hipLaunchKernelGGL(mk_fwd, dim3(grid), dim3(NTHR), LDS_BYTES, stream, p); }
#endif
}
```

```cpp
#include <hip/hip_runtime.h>
#include <hip/hip_cooperative_groups.h>
#include <cstdio>
#include <cstdint>
namespace cg = cooperative_groups;
namespace pg8 {
#define PG8_LAS __attribute__((address_space(3)))
typedef unsigned short bf16_t;
typedef short bf16x8 __attribute__((ext_vector_type(8)));
typedef _Float16 f16x8 __attribute__((ext_vector_type(8)));
typedef float f32x4 __attribute__((ext_vector_type(4)));
typedef unsigned u32x4 __attribute__((ext_vector_type(4)));
constexpr int BM = 256, BK = 64, HALF = 128, HTB = HALF * BK * 2  , STAGE_BYTES = 8 * HTB, NXCD = 8, WGM = 8;

__host__ __device__ __forceinline__ int lds_byte(int r, int c) { const int st = (r >> 4) * 2 + (c >> 5), rr = r & 15, cc = c & 31, ob = rr * 64 + cc * 2; return st * 1024 + (ob ^ (((ob >> 9) & 1) << 5)); }
__host__ __device__ __forceinline__ void stage_rc(int b, int& R, int& C) { const int st = b / 1024, sb = b % 1024, swz = sb ^ (((sb >> 9) & 1) << 5); R = (st >> 1) * 16 + swz / 64; C = (st & 1) * 32 + (swz % 64) / 2; }
__host__ __device__ __forceinline__ int perm32(int rho) { const int n = rho >> 4, i = rho & 15; return 8 * (i >> 2) + 4 * n + (i & 3); }

struct Unit { int pm, pn, ord; };
struct Gemm { const bf16_t* A; const bf16_t* Bt; int M, N, K; };

struct StaticOrder {
    int nM, nN, nwg, G, c;
    __host__ __device__ void init(int M, int N, int G_, int c_) { nM = M / BM; nN = N / BM; nwg = nM * nN; G = G_; c = c_; }
    __host__ __device__ bool next(int i, Unit& u) const {
        const long L = (long)i * G + c; if (L >= nwg) return false;
        int wgid = (int)L; { const int q = nwg / NXCD, r = nwg % NXCD, xcd = wgid % NXCD, off = wgid / NXCD; wgid = (xcd < r ? xcd * (q + 1) : r * (q + 1) + (xcd - r) * q) + off; }
        const int nig = WGM * nN, gid = wgid / nig, fm = gid * WGM, gsz = (nM - fm) < WGM ? (nM - fm) : WGM;
        u.pm = fm + ((wgid % nig) % gsz); u.pn = (wgid % nig) / gsz; u.ord = i; return true;
    }
    __device__ __forceinline__ void a_ready(const Unit&) const {}
    __device__ __forceinline__ void done(const Unit&) const {}
};


template <class Epi, class Sched, bool ALIGN_EPI = false, bool SP2 = false>
__device__ __forceinline__ void gemm_phase(PG8_LAS unsigned char* lds, const Gemm g, const Sched& S, const Epi& E) {
    int tid_ = threadIdx.x; asm volatile("" : "+v"(tid_));
    const int tid = tid_, wid = __builtin_amdgcn_readfirstlane(tid >> 6), lane = tid & 63, wr = wid >> 2, wc = wid & 3, fr = lane & 15, fq = lane >> 4;
    const int K = g.K, nt = K / BK;
    unsigned voffA[2], voffB[2];
#pragma unroll
    for (int i = 0; i < 2; ++i) { int R, C; stage_rc(tid * 16 + i * 8192, R, C); const int Rb = Epi::PERM ? ((R & ~31) + perm32(R & 31)) : R;
        voffA[i] = (unsigned)(R * K + C) * 2u; voffB[i] = (unsigned)(Rb * K + C) * 2u; }
    const size_t kstep = (size_t)(BK * 2);
    const size_t hstep = (size_t)HALF * K * 2;
    const size_t tstep = 2 * hstep;
    const unsigned ldsw = (unsigned)wid * 1024u;
    const int aoff = lds_byte(wr * 64 + fr, fq * 8), boff = lds_byte(wc * 32 + fr, fq * 8);
#define PG8_SA(b, h) (((b) * 2 + (h)) * HTB)
#define PG8_SB(b, h) ((4 + (b) * 2 + (h)) * HTB)
#define PG8_STAGE(bufoff, gbase, voff) do { _Pragma("unroll") for (int _i = 0; _i < 2; ++_i) \
        __builtin_amdgcn_global_load_lds((const unsigned*)((const char*)(gbase) + (voff)[_i]), (PG8_LAS unsigned*)(lds + (bufoff) + ldsw + _i * 8192), 16, 0, 0); } while (0)
#define PG8_LDA(dst, b, h) do { _Pragma("unroll") for (int m = 0; m < 4; ++m) _Pragma("unroll") for (int k = 0; k < 2; ++k) dst[m][k] = *(const PG8_LAS f16x8*)(lds + PG8_SA(b, h) + aoff + m * 2048 + k * 1024); } while (0)
#define PG8_LDB(dst, b, h) do { _Pragma("unroll") for (int n = 0; n < 2; ++n) _Pragma("unroll") for (int k = 0; k < 2; ++k) dst[n][k] = *(const PG8_LAS f16x8*)(lds + PG8_SB(b, h) + boff + n * 2048 + k * 1024); } while (0)
#define PG8_MMA(ai, bj, At, Bt) do { __builtin_amdgcn_s_setprio(1); _Pragma("unroll") for (int m = 0; m < 4; ++m) _Pragma("unroll") for (int n = 0; n < 2; ++n) _Pragma("unroll") for (int k = 0; k < 2; ++k) \
        acc[ai][bj][m][n] = __builtin_amdgcn_mfma_f32_16x16x32_f16(Bt[n][k], At[m][k], acc[ai][bj][m][n], 0, 0, 0); __builtin_amdgcn_s_setprio(0); } while (0)
#define PG8_WAIT_V(n) asm volatile("s_waitcnt vmcnt(" #n ")" ::: "memory")
#define PG8_WAIT_L(n) asm volatile("s_waitcnt lgkmcnt(" #n ")" ::: "memory")
#define PG8_BAR __builtin_amdgcn_s_barrier()
#define PG8_SCHED __builtin_amdgcn_sched_barrier(0)
    Unit cur, nxt; int ui = 0;
    if (!S.next(0, cur)) return;
    f32x4 acc[2][2][4][2];
#pragma unroll
    for (int a = 0; a < 2; ++a)
#pragma unroll
        for (int b = 0; b < 2; ++b)
#pragma unroll
            for (int m = 0; m < 4; ++m)
#pragma unroll
                for (int n = 0; n < 2; ++n) acc[a][b][m][n] = (f32x4){0.f, 0.f, 0.f, 0.f};
    f16x8 At[4][2], B0[2][2], B1[2][2];
    const char* cA = (const char*)g.A + (size_t)cur.pm * tstep; const char* cB = (const char*)g.Bt + (size_t)cur.pn * tstep;
    S.a_ready(cur);
    if constexpr (SP2) {
        PG8_STAGE(PG8_SB(0, 0), cB, voffB); PG8_STAGE(PG8_SB(0, 1), cB + hstep, voffB); PG8_STAGE(PG8_SA(0, 0), cA, voffA); PG8_STAGE(PG8_SA(0, 1), cA + hstep, voffA);
        if (wr == 1) PG8_BAR;
        PG8_WAIT_V(2); PG8_BAR;
        PG8_STAGE(PG8_SB(1, 0), cB + kstep, voffB); PG8_STAGE(PG8_SA(1, 0), cA + kstep, voffA); PG8_STAGE(PG8_SB(1, 1), cB + hstep + kstep, voffB);
        PG8_WAIT_V(6); PG8_BAR;
    } else {
        PG8_STAGE(PG8_SB(0, 0), cB, voffB); PG8_STAGE(PG8_SA(0, 0), cA, voffA); PG8_STAGE(PG8_SB(0, 1), cB + hstep, voffB); PG8_STAGE(PG8_SA(0, 1), cA + hstep, voffA);
        if (wr == 1) PG8_BAR;
        PG8_WAIT_V(4); PG8_BAR;
        PG8_STAGE(PG8_SB(1, 0), cB + kstep, voffB); PG8_STAGE(PG8_SA(1, 0), cA + kstep, voffA); PG8_STAGE(PG8_SB(1, 1), cB + hstep + kstep, voffB);
        PG8_WAIT_V(6); PG8_BAR;
    }
    for (;;) {
        const bool has_next = S.next(ui + 1, nxt);
        const char* nA = has_next ? (const char*)g.A + (size_t)nxt.pm * tstep : cA; const char* nB = has_next ? (const char*)g.Bt + (size_t)nxt.pn * tstep : cB;
        for (int t = 0; t < nt; t += 2) {
            const bool last = (t == nt - 2);
            const char* a1 = cA + (size_t)(t + 1) * kstep;
            const char* a2 = last ? nA : cA + (size_t)(t + 2) * kstep; const char* b2 = last ? nB : cB + (size_t)(t + 2) * kstep;
            const char* a3 = a2 + kstep; const char* b3 = b2 + kstep;
            if (last && has_next) S.a_ready(nxt);
            if constexpr (SP2) {
            PG8_LDB(B0, 0, 0); PG8_LDB(B1, 0, 1); PG8_SCHED; PG8_LDA(At, 0, 0); PG8_STAGE(PG8_SA(1, 1), a1 + hstep, voffA);
            PG8_WAIT_V(8); PG8_WAIT_L(0); PG8_BAR; PG8_MMA(0, 0, At, B0); PG8_MMA(0, 1, At, B1); PG8_BAR; PG8_SCHED;
            PG8_LDA(At, 0, 1); PG8_STAGE(PG8_SB(0, 0), b2, voffB); PG8_STAGE(PG8_SB(0, 1), b2 + hstep, voffB); PG8_STAGE(PG8_SA(0, 0), a2, voffA);
            PG8_WAIT_V(8); PG8_WAIT_L(0); PG8_BAR; PG8_MMA(1, 0, At, B0); PG8_MMA(1, 1, At, B1); PG8_BAR; PG8_SCHED;
            PG8_LDB(B0, 1, 0); PG8_LDB(B1, 1, 1); PG8_SCHED; PG8_LDA(At, 1, 0); PG8_STAGE(PG8_SA(0, 1), a2 + hstep, voffA);
            PG8_WAIT_V(8); PG8_WAIT_L(0); PG8_BAR; PG8_MMA(0, 0, At, B0); PG8_MMA(0, 1, At, B1); PG8_BAR; PG8_SCHED;
            PG8_LDA(At, 1, 1); PG8_STAGE(PG8_SB(1, 0), b3, voffB); PG8_STAGE(PG8_SB(1, 1), b3 + hstep, voffB); PG8_STAGE(PG8_SA(1, 0), a3, voffA);
            PG8_WAIT_V(8); PG8_WAIT_L(0); PG8_BAR; PG8_MMA(1, 0, At, B0); PG8_MMA(1, 1, At, B1); PG8_BAR; PG8_SCHED;
            } else {
            PG8_LDB(B0, 0, 0); PG8_SCHED; PG8_LDA(At, 0, 0); PG8_STAGE(PG8_SA(1, 1), a1 + hstep, voffA);
            PG8_WAIT_L(8); PG8_BAR; PG8_WAIT_L(0); PG8_MMA(0, 0, At, B0); PG8_BAR; PG8_SCHED;
            PG8_LDB(B1, 0, 1); PG8_STAGE(PG8_SB(0, 0), b2, voffB);
            PG8_BAR; PG8_WAIT_L(0); PG8_MMA(0, 1, At, B1); PG8_BAR;
            PG8_LDA(At, 0, 1); PG8_STAGE(PG8_SA(0, 0), a2, voffA);
            PG8_BAR; PG8_WAIT_L(0); PG8_MMA(1, 0, At, B0); PG8_BAR; PG8_SCHED;
            PG8_STAGE(PG8_SB(0, 1), b2 + hstep, voffB);
            PG8_WAIT_V(6); PG8_BAR; PG8_MMA(1, 1, At, B1); PG8_BAR;
            PG8_LDB(B0, 1, 0); PG8_SCHED; PG8_LDA(At, 1, 0); PG8_STAGE(PG8_SA(0, 1), a2 + hstep, voffA);
            PG8_WAIT_L(8); PG8_BAR; PG8_WAIT_L(0); PG8_MMA(0, 0, At, B0); PG8_BAR; PG8_SCHED;
            PG8_LDB(B1, 1, 1); PG8_STAGE(PG8_SB(1, 0), b3, voffB);
            PG8_BAR; PG8_WAIT_L(0); PG8_MMA(0, 1, At, B1); PG8_BAR;
            PG8_LDA(At, 1, 1); PG8_STAGE(PG8_SA(1, 0), a3, voffA);
            PG8_BAR; PG8_WAIT_L(0); PG8_MMA(1, 0, At, B0); PG8_BAR; PG8_SCHED;
            PG8_STAGE(PG8_SB(1, 1), b3 + hstep, voffB);
            PG8_WAIT_V(6); PG8_BAR; PG8_MMA(1, 1, At, B1); PG8_BAR;
            }
        }
        if constexpr (ALIGN_EPI) { if (wr == 0) PG8_BAR; }
        if constexpr (!Epi::AFTER_DRAIN) { E(acc, cur, wr, wc, fr, fq); S.done(cur); }
        if (!has_next) break;
#pragma unroll
        for (int a = 0; a < 2; ++a)
#pragma unroll
            for (int b = 0; b < 2; ++b)
#pragma unroll
                for (int m = 0; m < 4; ++m)
#pragma unroll
                    for (int n = 0; n < 2; ++n) acc[a][b][m][n] = (f32x4){0.f, 0.f, 0.f, 0.f};
        cur = nxt; cA = nA; cB = nB; ++ui;
        if constexpr (ALIGN_EPI) { if (wr == 1) PG8_BAR; }
    }
    PG8_WAIT_V(0);
    if constexpr (!ALIGN_EPI) { if (wr == 0) PG8_BAR; }
    PG8_BAR;
    if constexpr (Epi::AFTER_DRAIN) { E.fused(acc, cur, wr, wc, fr, fq, lds, wid, lane); S.done(cur); }
#undef PG8_SA
#undef PG8_SB
#undef PG8_STAGE
#undef PG8_LDA
#undef PG8_LDB
#undef PG8_MMA
#undef PG8_WAIT_V
#undef PG8_WAIT_L
#undef PG8_BAR
#undef PG8_SCHED
}
}


constexpr int D = 1024, NB = 8, S = 2048, NL = 4, M = NB * S;
constexpr int DIN = 4224, DSH = 2176, DR = 512, NH = 8, HD = 64, NREL = 192;
constexpr int NP = 4352;
constexpr int PC_R = 0, PC_K = 512, PC_V = 1024, PC_G = 1536, PC_WD = 2048, PC_AD = 2112, PC_Q = 2304, PC_KA = 2816, PC_VA = 3328, PC_GA = 3840;
constexpr int NWAVES = 8, NTHR = 512;
constexpr size_t SW_HALF = (size_t)8 * NP;
constexpr size_t MiB = 1u << 20;
constexpr size_t WS_W2T = 1 * MiB + 512 * 1024, WS_A2T = 1 * MiB + 768 * 1024, WS_BDG = 256 * 1024  ;
constexpr size_t WS_CTL = 0, WS_MOD = 1 * MiB, WS_SW = 2 * MiB, WS_PART = 3 * MiB, WS_WINT = 4 * MiB  , WS_WOUTT = 12 * MiB + 512 * 1024  ,
                 WS_AX = 16 * MiB + 512 * 1024, WS_YB = 48 * MiB + 512 * 1024, WS_PROJ = 80 * MiB + 512 * 1024, WS_IMGB = 216 * MiB + 512 * 1024, WS_END = 264 * MiB;
constexpr int IMG_BYTES = 10048, IMG_NA = 26 * 128;
constexpr int IM_WT = 0, IM_RH = 2048, IM_BB = 4096, IM_KB = 6144, IM_MUKT = 8192, IM_ARBT = 8704, IM_ARKT = 9216, IM_GAM = 9728, IM_BD = 9984;
static_assert((size_t)IMG_NA * IMG_BYTES <= 32 * MiB && (size_t)(8192 - IMG_NA) * IMG_BYTES <= WS_END - WS_IMGB, "image storage");
__device__ __forceinline__ unsigned char* img_ptr(unsigned char* ws, int unit) { return unit < IMG_NA ? ws + WS_AX + (size_t)unit * IMG_BYTES : ws + WS_IMGB + (size_t)(unit - IMG_NA) * IMG_BYTES; }
constexpr int LDS_BYTES = 147456;
constexpr int LDS_RSTD = 131072, P1_MAXU = 6, LDS_SVT = LDS_RSTD + P1_MAXU * 1024;
constexpr int LDS_MISC = 147456 - 256;
constexpr int CW_Q = 9216;
constexpr int CW_BAR = 4096;

#define GAS __attribute__((address_space(1)))
#define LAS __attribute__((address_space(3)))
typedef unsigned short u16;
typedef float f32x4 __attribute__((ext_vector_type(4)));
typedef float f32x2 __attribute__((ext_vector_type(2)));
typedef unsigned u32x4 __attribute__((ext_vector_type(4)));
typedef unsigned u32x2 __attribute__((ext_vector_type(2)));
typedef _Float16 f16x2 __attribute__((ext_vector_type(2)));
typedef _Float16 f16x4 __attribute__((ext_vector_type(4)));
typedef _Float16 f16x8 __attribute__((ext_vector_type(8)));

__device__ __forceinline__ unsigned pk_f16(float lo, float hi) { f32x2 v = {lo, hi}; f16x2 h = __builtin_convertvector(v, f16x2); return __builtin_bit_cast(unsigned, h); }
__device__ __forceinline__ float h2f(u16 h) { return (float)__builtin_bit_cast(_Float16, h); }
__device__ __forceinline__ u16 f2h(float f) { return __builtin_bit_cast(u16, (_Float16)f); }
__device__ __forceinline__ float wave_sum(float v) {
#pragma unroll
    for (int o = 1; o < 64; o <<= 1) v += __shfl_xor(v, o);
    return v;
}
__device__ __forceinline__ float red_x32(float x) {
    auto r32 = __builtin_amdgcn_permlane32_swap(__float_as_uint(x), __float_as_uint(x), false, false);
    return __uint_as_float(r32[0]) + __uint_as_float(r32[1]); }
__device__ __forceinline__ float red_rows(float x) {
    auto r16 = __builtin_amdgcn_permlane16_swap(__float_as_uint(x), __float_as_uint(x), false, false);
    return red_x32(__uint_as_float(r16[0]) + __uint_as_float(r16[1])); }
__device__ __forceinline__ float sigmoidf_(float x) { return 1.f / (1.f + __expf(-x)); }
__device__ __forceinline__ void st16_wt(void* p, u32x4 v) { asm volatile("global_store_dwordx4 %0, %1, off sc1\n\ts_nop 1" :: "v"(p), "v"(v) : "memory"); }

struct Params {
    const float *x, *c, *norm_g, *w_ada, *b_ada, *w_in, *mu, *w0, *w2, *a0, *a2, *k_k, *k_a, *r_k, *lnx_g, *lnx_b, *qg, *kg, *rel_bias, *w_out;
    float* out; unsigned char* ws; int ph_lo, ph_hi;
};
typedef const __attribute__((address_space(4))) Params CP;


typedef GAS unsigned gu32;
#define XB_TMO      128
#define XB_XCNT(j)  (256  + 64 * (j))
#define XB_XSUB(j)  (1280 + 64 * (j))
#define XB_XGEN(j)  (2304 + 64 * (j))
#define XB_TOP      3328
#define XB_TOPGEN   3392
#define XCD_BAR_WORDS 3456
#define FB_CNT      3520
#define FB_REL(j)   (3584 + 64 * (j))
#define XB_SPIN_CAP (1u << 18)

__device__ __forceinline__ unsigned xb_ld(unsigned* p)              { return __hip_atomic_load(p, __ATOMIC_RELAXED, __HIP_MEMORY_SCOPE_AGENT); }
__device__ __forceinline__ unsigned xb_add(unsigned* p, unsigned v) { return __hip_atomic_fetch_add(p, v, __ATOMIC_RELAXED, __HIP_MEMORY_SCOPE_AGENT); }
__device__ __forceinline__ unsigned xb_xcc_id() { return (unsigned)__builtin_amdgcn_s_getreg((3 << 11) | 20) & 0xFu; }
#define XB_SPIN(cond, bar) do { unsigned _sp = 0; while (cond) { __builtin_amdgcn_s_sleep(1); \
    if ((++_sp & 255u) == 0u) { if (xb_ld(&(bar)[XB_TMO])) break; if (_sp > XB_SPIN_CAP) { atomicAdd(&(bar)[XB_TMO], 1u); break; } } } } while (0)

struct XcdBarrier {
    unsigned* bar; unsigned x;
    volatile LAS unsigned* st;
};

__device__ __forceinline__ XcdBarrier xcd_barrier_post(unsigned* bar, volatile LAS unsigned* st) {
    XcdBarrier b; b.bar = bar; b.x = xb_xcc_id(); b.st = st;
    if (threadIdx.x == 0) (void)xb_add(&bar[XB_XCNT(b.x)], 1u);
    return b;
}
__device__ __forceinline__ void xcd_barrier_complete(unsigned* bar, unsigned x, unsigned& nloc, unsigned& nx) {
    const unsigned G = gridDim.x * gridDim.y * gridDim.z;
    unsigned sum, cnt, mine, sp = 0u;
    for (;;) {
        sum = 0u; cnt = 0u; mine = 0u;
#pragma unroll
        for (unsigned j = 0; j < 16; ++j) { const unsigned c = xb_ld(&bar[XB_XCNT(j)]); sum += c; cnt += (c > 0u) ? 1u : 0u; mine = (j == x) ? c : mine; }
        if (sum == G) break;
        __builtin_amdgcn_s_sleep(1);
        if ((++sp & 255u) == 0u) { if (xb_ld(&bar[XB_TMO])) break; if (sp > XB_SPIN_CAP) { atomicAdd(&bar[XB_TMO], 1u); break; } }
    }
    nloc = mine > 0u ? mine : 1u; nx = cnt > 0u ? cnt : 1u;
}

__device__ __forceinline__ void xcd_barrier(const XcdBarrier& b, bool wb = true) {
    asm volatile("s_waitcnt vmcnt(0)" ::: "memory");
    __syncthreads();
    if (threadIdx.x == 0) {
        unsigned* bar = b.bar;
        __builtin_amdgcn_s_waitcnt(0);
        unsigned nloc = b.st[0], nx = b.st[1];
        if (nloc == 0u) { xcd_barrier_complete(bar, b.x, nloc, nx); b.st[0] = nloc; b.st[1] = nx; }
        asm volatile("buffer_inv sc1" ::: "memory");
        const unsigned old = xb_add(&bar[XB_XSUB(b.x)], 1u);
        const unsigned gen = old / nloc;
        if (old + 1u == (gen + 1u) * nloc) {
            if (wb) __builtin_amdgcn_fence(__ATOMIC_RELEASE, "agent");
            asm volatile("s_waitcnt vmcnt(0)" ::: "memory");
            (void)xb_add(&bar[XB_TOP], 1u);
            XB_SPIN(xb_ld(&bar[XB_TOP]) < (gen + 1u) * nx, bar);
            xb_add(&bar[XB_XGEN(b.x)], 1u);
            asm volatile("s_waitcnt vmcnt(0)" ::: "memory");
        } else {
            XB_SPIN(xb_ld(&bar[XB_XGEN(b.x)]) == gen, bar);
            asm volatile("s_waitcnt vmcnt(0)" ::: "memory");
        }
    }
    __syncthreads();
}

__device__ __forceinline__ void flat_barrier(const XcdBarrier& b, unsigned k) {
    asm volatile("s_waitcnt vmcnt(0)" ::: "memory");
    __syncthreads();
    if (threadIdx.x == 0) {
        unsigned* bar = b.bar; const unsigned G = gridDim.x * gridDim.y * gridDim.z;
        asm volatile("buffer_inv sc1" ::: "memory");
        const unsigned old = xb_add(&bar[FB_CNT], 1u);
        if (old + 1u == (k + 1u) * G) {
#pragma unroll
            for (int j = 0; j < 16; ++j) __hip_atomic_store(&bar[FB_REL(j)], k + 1u, __ATOMIC_RELAXED, __HIP_MEMORY_SCOPE_AGENT);
        } else XB_SPIN(xb_ld(&bar[FB_REL(b.x & 15u)]) < k + 1u, bar);
        asm volatile("s_waitcnt vmcnt(0)" ::: "memory");
    }
    __syncthreads();
}

struct EpiProj {
    static constexpr bool PERM = true, AFTER_DRAIN = false;
    u16* O; const LAS float* svt; const LAS float* rstd;
    __device__ __forceinline__ void operator()(const pg8::f32x4 (&acc)[2][2][4][2], const pg8::Unit& u, int wr, int wc, int fr, int fq) const {
        const int col0 = u.pn * 256 + wc * 32 + 8 * fq;
        f32x4 sv[2][2];
#pragma unroll
        for (int bj = 0; bj < 2; ++bj)
#pragma unroll
            for (int n = 0; n < 2; ++n) sv[bj][n] = *(const LAS f32x4*)(svt + u.ord * 256 + wc * 32 + 8 * fq + bj * 128 + 4 * n);
#pragma unroll
        for (int ai = 0; ai < 2; ++ai)
#pragma unroll
            for (int m = 0; m < 4; ++m) {
                const int rl = ai * 128 + wr * 64 + m * 16 + fr; const float rs = rstd[u.ord * 256 + rl];
                u16* rowp = O + (size_t)(u.pm * 256 + rl) * NP + col0;
#pragma unroll
                for (int bj = 0; bj < 2; ++bj) {
                    const f32x4 v0 = acc[ai][bj][m][0] * rs + sv[bj][0], v1 = acc[ai][bj][m][1] * rs + sv[bj][1];
                    u32x4 w; w.x = pk_f16(v0[0], v0[1]); w.y = pk_f16(v0[2], v0[3]); w.z = pk_f16(v1[0], v1[1]); w.w = pk_f16(v1[2], v1[3]);
                    *(u32x4*)(rowp + bj * 128) = w; }
            }
    }
};
struct EpiOut {
    static constexpr bool PERM = true, AFTER_DRAIN = false;
    const float* xold; float* xout; const LAS float* gt;   const LAS float* Gt;   bool ng;   u16* AX; float* part;
    __device__ __forceinline__ void operator()(const pg8::f32x4 (&acc)[2][2][4][2], const pg8::Unit& u, int wr, int wc, int fr, int fq) const {
        const int col0 = u.pn * 256 + wc * 32 + 8 * fq;
        const int cl0 = wc * 32 + 8 * fq;
        constexpr int PD = 3; f32x4 xq[8][2][2];
        auto xload = [&](int g) { const int r = u.pm * 256 + (g >> 2) * 128 + wr * 64 + (g & 3) * 16 + fr;
#pragma unroll
            for (int bj = 0; bj < 2; ++bj) { const size_t off = (size_t)r * D + col0 + bj * 128;
                xq[g][bj][0] = __builtin_nontemporal_load((const f32x4*)(xold + off)); xq[g][bj][1] = __builtin_nontemporal_load((const f32x4*)(xold + off + 4)); } };
#pragma unroll
        for (int g = 0; g < PD; ++g) xload(g);
#pragma unroll
        for (int ai = 0; ai < 2; ++ai)
#pragma unroll
            for (int m = 0; m < 4; ++m) {
                const int r = u.pm * 256 + ai * 128 + wr * 64 + m * 16 + fr; float ss = 0.f;
                if (ai * 4 + m + PD < 8) xload(ai * 4 + m + PD);
#pragma unroll
                for (int bj = 0; bj < 2; ++bj) {
                    const size_t off = (size_t)r * D + col0 + bj * 128;
                    const f32x4 x0 = xq[ai * 4 + m][bj][0], x1 = xq[ai * 4 + m][bj][1];
                    const f32x4 gv0 = *(const LAS f32x4*)(gt + cl0 + bj * 128), gv1 = *(const LAS f32x4*)(gt + cl0 + bj * 128 + 4);
                    const f32x4 n0 = x0 + gv0 * acc[ai][bj][m][0], n1 = x1 + gv1 * acc[ai][bj][m][1];
                    *(f32x4*)(xout + off) = n0; *(f32x4*)(xout + off + 4) = n1;
                    ss += (n0[0] * n0[0] + n0[1] * n0[1]) + (n0[2] * n0[2] + n0[3] * n0[3]) + (n1[0] * n1[0] + n1[1] * n1[1]) + (n1[2] * n1[2] + n1[3] * n1[3]);
                    if (ng) { const f32x4 a0 = n0 * *(const LAS f32x4*)(Gt + cl0 + bj * 128), a1 = n1 * *(const LAS f32x4*)(Gt + cl0 + bj * 128 + 4);
                        u32x4 w; w.x = pk_f16(a0[0], a0[1]); w.y = pk_f16(a0[2], a0[3]); w.z = pk_f16(a1[0], a1[1]); w.w = pk_f16(a1[2], a1[3]);
                        *(u32x4*)(AX + off) = w; }
                }
                ss += __shfl_xor(ss, 16); ss += __shfl_xor(ss, 32);
                if (ng && fq == 0) part[(size_t)r * 16 + u.pn * 4 + wc] = ss;
            }
    }
};

struct Frame {
    LAS unsigned char* lds; int tid, lane, wave, G, bid;
};

template <int MODE>
__device__ __forceinline__ void gemv8_item(Frame& F, const LAS float* vec, const float* W, int ldw, int n0, const float* bias, float* outp, int ldo) {
    LAS float* red = (LAS float*)(F.lds + 65536);
    const int n = n0 + F.lane; int src = n; bool valid = true;
    if (MODE == 1) { if (n < DSH) src = n; else if (n < PC_Q) { valid = false; src = 0; } else src = n - 128; }
    float acc[8];
#pragma unroll
    for (int b = 0; b < 8; ++b) acc[b] = 0.f;
    if (MODE == 0) {
#define GV_BLK(w0, w1, w2, w3, w4, w5, w6, w7) asm volatile( \
            "global_load_dword %0, %8, %9 nt\n\tv_add_u32 %8, %10, %8\n\tglobal_load_dword %1, %8, %9 nt\n\tv_add_u32 %8, %10, %8\n\t" \
            "global_load_dword %2, %8, %9 nt\n\tv_add_u32 %8, %10, %8\n\tglobal_load_dword %3, %8, %9 nt\n\tv_add_u32 %8, %10, %8\n\t" \
            "global_load_dword %4, %8, %9 nt\n\tv_add_u32 %8, %10, %8\n\tglobal_load_dword %5, %8, %9 nt\n\tv_add_u32 %8, %10, %8\n\t" \
            "global_load_dword %6, %8, %9 nt\n\tv_add_u32 %8, %10, %8\n\tglobal_load_dword %7, %8, %9 nt\n\tv_add_u32 %8, %10, %8" \
            : "=&v"(w0), "=&v"(w1), "=&v"(w2), "=&v"(w3), "=&v"(w4), "=&v"(w5), "=&v"(w6), "=&v"(w7), "+v"(voff) : "s"(wbase), "s"(rstride))
#define GV_WAIT(N, a) asm volatile("s_waitcnt vmcnt(" #N ")" : "+v"(a[0]), "+v"(a[1]), "+v"(a[2]), "+v"(a[3]), "+v"(a[4]), "+v"(a[5]), "+v"(a[6]), "+v"(a[7]), "+v"(a[8]), "+v"(a[9]), "+v"(a[10]), "+v"(a[11]), \
            "+v"(a[12]), "+v"(a[13]), "+v"(a[14]), "+v"(a[15]))
        const float* wbase = W + (size_t)(F.wave * 128) * ldw; const int rstride = ldw * 4; int voff = src * 4;
#pragma unroll 1
        for (int k0 = 0; k0 < 128; k0 += 32) {
            float wa[16], wb[16];
            GV_BLK(wa[0], wa[1], wa[2], wa[3], wa[4], wa[5], wa[6], wa[7]); GV_BLK(wa[8], wa[9], wa[10], wa[11], wa[12], wa[13], wa[14], wa[15]);
            GV_BLK(wb[0], wb[1], wb[2], wb[3], wb[4], wb[5], wb[6], wb[7]); GV_BLK(wb[8], wb[9], wb[10], wb[11], wb[12], wb[13], wb[14], wb[15]);
            GV_WAIT(16, wa);
#pragma unroll
            for (int k4 = 0; k4 < 16; k4 += 4)
#pragma unroll
                for (int b = 0; b < 8; ++b) { const f32x4 vv = *(const LAS f32x4*)(vec + b * 1024 + F.wave * 128 + k0 + k4);
                    acc[b] += (vv[0] * wa[k4] + vv[1] * wa[k4 + 1]) + (vv[2] * wa[k4 + 2] + vv[3] * wa[k4 + 3]); }
            GV_WAIT(0, wb);
#pragma unroll
            for (int k4 = 0; k4 < 16; k4 += 4)
#pragma unroll
                for (int b = 0; b < 8; ++b) { const f32x4 vv = *(const LAS f32x4*)(vec + b * 1024 + F.wave * 128 + k0 + 16 + k4);
                    acc[b] += (vv[0] * wb[k4] + vv[1] * wb[k4 + 1]) + (vv[2] * wb[k4 + 2] + vv[3] * wb[k4 + 3]); }
        }
#undef GV_BLK
#undef GV_WAIT
    } else {
    const float* wp = W + (size_t)(F.wave * 128) * ldw + src;
#pragma unroll 1
    for (int k0 = 0; k0 < 128; k0 += 16) {
        float wv[16];
#pragma unroll
        for (int k = 0; k < 16; ++k) wv[k] = valid ? __builtin_nontemporal_load(wp + (size_t)(k0 + k) * ldw) : 0.f;
#pragma unroll
        for (int k4 = 0; k4 < 16; k4 += 4)
#pragma unroll
            for (int b = 0; b < 8; ++b) { const f32x4 vv = *(const LAS f32x4*)(vec + b * 1024 + F.wave * 128 + k0 + k4);
                acc[b] += (vv[0] * wv[k4] + vv[1] * wv[k4 + 1]) + (vv[2] * wv[k4 + 2] + vv[3] * wv[k4 + 3]); }
    }
    }
#pragma unroll
    for (int b = 0; b < 8; ++b) red[(F.wave * 8 + b) * 64 + F.lane] = acc[b];
    __syncthreads();
    { const int b = F.tid >> 6, ln = F.tid & 63; float s = 0.f;
#pragma unroll
      for (int w = 0; w < 8; ++w) s += red[(w * 8 + b) * 64 + ln];
      const int nn = n0 + ln;
      outp[(size_t)b * ldo + nn] = s + (bias ? bias[nn] : 0.f); }
    __syncthreads();
}

__device__ __forceinline__ void gemv8h_item(Frame& F, const LAS float* vec, const float* W, int ldw, int n0, int half, float* outp, int ldo) {
    LAS float* red = (LAS float*)(F.lds + 65536);
    const int n = n0 + F.lane; int src = n; bool valid = true;
    if (n < DSH) src = n; else if (n < PC_Q) { valid = false; src = 0; } else src = n - 128;
    float acc[8];
#pragma unroll
    for (int b = 0; b < 8; ++b) acc[b] = 0.f;
    const int kb = half * 512 + F.wave * 64;
    const float* wp = W + (size_t)kb * ldw + src;
#pragma unroll 1
    for (int k0 = 0; k0 < 64; k0 += 16) {
        float wv[16];
#pragma unroll
        for (int k = 0; k < 16; ++k) wv[k] = valid ? __builtin_nontemporal_load(wp + (size_t)(k0 + k) * ldw) : 0.f;
#pragma unroll
        for (int k4 = 0; k4 < 16; k4 += 4)
#pragma unroll
            for (int b = 0; b < 8; ++b) { const f32x4 vv = *(const LAS f32x4*)(vec + b * 1024 + kb + k0 + k4);
                acc[b] += (vv[0] * wv[k4] + vv[1] * wv[k4 + 1]) + (vv[2] * wv[k4 + 2] + vv[3] * wv[k4 + 3]); }
    }
#pragma unroll
    for (int b = 0; b < 8; ++b) red[(F.wave * 8 + b) * 64 + F.lane] = acc[b];
    __syncthreads();
    { const int b = F.tid >> 6, ln = F.tid & 63; float sacc = 0.f;
#pragma unroll
      for (int w = 0; w < 8; ++w) sacc += red[(w * 8 + b) * 64 + ln];
      outp[(size_t)b * ldo + n0 + ln] = sacc; }
    __syncthreads();
}
__device__ __forceinline__ void p0a_mod(Frame& F, CP& p) {
    LAS float* vec = (LAS float*)F.lds;
    for (int i = F.tid; i < 8 * 1024; i += NTHR) { const float v = p.c[i]; vec[i] = v * sigmoidf_(v); }
    __syncthreads();
    float* MOD = (float*)(p.ws + WS_MOD);
    for (int it = F.bid; it < NL * 48; it += F.G) { const int l = it / 48, nb = it % 48;
        gemv8_item<0>(F, vec, p.w_ada + (size_t)l * D * 3072, 3072, nb * 64, p.b_ada + l * 3072, MOD + (size_t)l * 8 * 3072, 3072); }
}

__device__ __forceinline__ void p0_transpose_item(const float* W, int K, int N, int ncol0_src, bool valid, u16* WT, int dst_row0, int k0, LAS float* scr, int lane) {
    { float tv[32];
#pragma unroll
      for (int i = 0; i < 32; ++i) { const int kk = 2 * i + (lane >> 5); tv[i] = valid ? __builtin_nontemporal_load(W + (size_t)(k0 + kk) * N + ncol0_src + (lane & 31)) : 0.f; }
#pragma unroll
      for (int i = 0; i < 32; ++i) { const int kk = 2 * i + (lane >> 5); scr[kk * 33 + (lane & 31)] = tv[i]; } }
    asm volatile("s_waitcnt lgkmcnt(0)" ::: "memory");
    const int cc = lane & 7;
#pragma unroll
    for (int j = 0; j < 4; ++j) { const int n = (lane >> 3) + 8 * j; const LAS float* s = scr + (8 * cc) * 33 + n;
        u32x4 o; o.x = pk_f16(s[0 * 33], s[1 * 33]); o.y = pk_f16(s[2 * 33], s[3 * 33]); o.z = pk_f16(s[4 * 33], s[5 * 33]); o.w = pk_f16(s[6 * 33], s[7 * 33]);
        *(u32x4*)(WT + (size_t)(dst_row0 + n) * K + k0 + 8 * cc) = o; }
    asm volatile("s_waitcnt lgkmcnt(0)" ::: "memory");
}

__device__ __forceinline__ void conv_weights_layer(Frame& F, CP& p, int l, int gw, int NGW, bool do_in = true, bool do_out = true) {
    u16* WINT = (u16*)(p.ws + WS_WINT); u16* WOUTT = (u16*)(p.ws + WS_WOUTT);
    LAS float* scr = (LAS float*)(F.lds + F.wave * 16384);
    constexpr int I_IN = 16 * (NP / 32), I_OUT = 16 * (D / 32);
    for (int it = gw + (do_in ? 0 : I_IN); it < (do_out ? I_IN + I_OUT : I_IN); it += NGW) { int r = it;
        if (r < I_IN) { const int kb = r / (NP / 32), nb = r % (NP / 32), n0 = nb * 32; int src = n0; bool valid = true;
            if (n0 >= DSH && n0 < PC_Q) { valid = false; src = 0; } else if (n0 >= PC_Q) src = n0 - 128;
            p0_transpose_item(p.w_in + (size_t)l * D * DIN, D, DIN, src, valid, WINT, n0, kb * 64, scr, F.lane); }
        else { r -= I_IN; const int kb = r / (D / 32), nb = r % (D / 32);
            p0_transpose_item(p.w_out + (size_t)l * D * D, D, D, nb * 32, true, WOUTT + (size_t)(l & 1) * D * D, nb * 32, kb * 64, scr, F.lane); } }
}
__device__ __forceinline__ void sw_layer(Frame& F, CP& p, int l, int g, int NG) {
    const float* MOD = (const float*)(p.ws + WS_MOD); float* SW = (float*)(p.ws + WS_SW) + (size_t)(l & 1) * 2 * SW_HALF;
    LAS float* vec = (LAS float*)F.lds;
    __syncthreads();
    for (int i = F.tid; i < 8 * 1024; i += NTHR) vec[i] = MOD[((size_t)l * 8 + (i >> 10)) * 3072 + (i & 1023)];
    __syncthreads();
    for (int it = g; it < 2 * (NP / 64); it += NG) { const int half = it & 1, nb = it >> 1;
        gemv8h_item(F, vec, p.w_in + (size_t)l * D * DIN, DIN, nb * 64, half, SW + (size_t)half * SW_HALF, NP); }
}
__device__ __forceinline__ void p0a_rest(Frame& F, CP& p) {
    conv_weights_layer(F, p, 0, F.bid * NWAVES + F.wave, F.G * NWAVES);
    u16* W2T = (u16*)(p.ws + WS_W2T); u16* A2T = (u16*)(p.ws + WS_A2T);
    for (int i = F.bid * NTHR + F.tid; i < NL * DR * 64; i += F.G * NTHR) { const int j = i & 63, c = (i >> 6) & 511, l = i >> 15;
        W2T[i] = f2h(p.w2[((size_t)l * 64 + j) * DR + c]); A2T[i] = f2h(p.a2[((size_t)l * 64 + j) * DR + c]); }
}
__device__ __forceinline__ void p0b(Frame& F, CP& p) {
    const float* MOD = (const float*)(p.ws + WS_MOD);
    sw_layer(F, p, 0, F.bid, F.G);
    { u16* AX = (u16*)(p.ws + WS_AX); float* PART = (float*)(p.ws + WS_PART);
      const int gw = F.bid * NWAVES + F.wave, NGW = F.G * NWAVES;
      for (int r0 = gw; r0 < M; r0 += 4 * NGW) {
          f32x4 xv[4][4];
#pragma unroll
          for (int q = 0; q < 4; ++q)
#pragma unroll
              for (int j = 0; j < 4; ++j) xv[q][j] = __builtin_nontemporal_load((const f32x4*)(p.x + (size_t)(r0 + q * NGW) * D + 4 * F.lane + 256 * j));
#pragma unroll
          for (int q = 0; q < 4; ++q) { const int r = r0 + q * NGW, b = r >> 11; float ss = 0.f;
#pragma unroll
              for (int j = 0; j < 4; ++j) { const int c = 4 * F.lane + 256 * j;
                  const f32x4 g = *(const f32x4*)(p.norm_g + c) * (1.0f + *(const f32x4*)(MOD + (size_t)b * 3072 + 1024 + c));
                  const f32x4 x4 = xv[q][j];
                  ss += (x4[0] * x4[0] + x4[1] * x4[1]) + (x4[2] * x4[2] + x4[3] * x4[3]);
                  const f32x4 a = x4 * g; u32x2 w; w.x = pk_f16(a[0], a[1]); w.y = pk_f16(a[2], a[3]);
                  *(u32x2*)(AX + (size_t)r * D + c) = w; }
              ss = wave_sum(ss);
              if (F.lane < 16) PART[(size_t)r * 16 + F.lane] = (F.lane == 0) ? ss : 0.f; } }
    }
}

__device__ __forceinline__ void p3_tables(Frame& F, CP& p, const pg8::StaticOrder& So, int l) {
    LAS float* gt = (LAS float*)(F.lds + LDS_RSTD); LAS float* Gt = gt + 256; const float* MOD = (const float*)(p.ws + WS_MOD);
    pg8::Unit u;
    if (So.next(0, u)) { const int b = u.pm >> 3, cc = F.tid & 255, col = u.pn * 256 + cc;
        if (F.tid < 256) gt[cc] = MOD[((size_t)l * 8 + b) * 3072 + 2048 + col];
        else Gt[cc] = (l + 1 < NL) ? p.norm_g[(l + 1) * D + col] * (1.0f + MOD[((size_t)(l + 1) * 8 + b) * 3072 + 1024 + col]) : 0.f; }
    __syncthreads();
}
__device__ __forceinline__ void p1_rstd(Frame& F, CP& p, const pg8::StaticOrder& So, int l) {
    LAS float* tab = (LAS float*)(F.lds + LDS_RSTD); const float* PART = (const float*)(p.ws + WS_PART);
    LAS float* svt = (LAS float*)(F.lds + LDS_SVT); const float* SW = (const float*)(p.ws + WS_SW) + (size_t)(l & 1) * 2 * SW_HALF;
    pg8::Unit u;
    for (int i = 0; So.next(i, u) && i < P1_MAXU; ++i) {
        if (F.tid >= 256) { const int cc = F.tid - 256; const size_t o = (size_t)(u.pm >> 3) * NP + u.pn * 256 + cc; svt[i * 256 + cc] = SW[o] + SW[SW_HALF + o]; }
        if (F.tid < 256) { const float* pr = PART + (size_t)(u.pm * 256 + F.tid) * 16; float s = 0.f;
#pragma unroll
            for (int j = 0; j < 4; ++j) { const f32x4 v = *(const f32x4*)(pr + 4 * j); s += (v[0] + v[1]) + (v[2] + v[3]); }
            tab[i * 256 + F.tid] = rsqrtf(s * (1.0f / D) + 1e-6f); }
    }
    __syncthreads();
}

typedef short s16x4 __attribute__((ext_vector_type(4)));
typedef short bf16x8 __attribute__((ext_vector_type(8)));
typedef float f32x16 __attribute__((ext_vector_type(16)));
typedef __bf16 bf16x2_t __attribute__((ext_vector_type(2)));
__device__ __forceinline__ unsigned pk_bf16(float lo, float hi) { f32x2 v = {lo, hi}; bf16x2_t b = __builtin_convertvector(v, bf16x2_t); return __builtin_bit_cast(unsigned, b); }
__device__ __forceinline__ s16x4 vtr(const LAS unsigned char* p) { return __builtin_bit_cast(s16x4, __builtin_amdgcn_ds_read_tr16_b64_v4i16((LAS s16x4*)p)); }
constexpr float LOG2E = 1.4426950408889634f;
constexpr int AT_K = 0, AT_V = 16384, AT_BIAS = 32768;

__device__ __forceinline__ void attn_wg_unit(Frame& F, CP& p, int l, int b, int h, int cgi, size_t yoff = WS_YB) {
    const u16* PROJ = (const u16*)(p.ws + WS_PROJ); u16* YO = (u16*)(p.ws + yoff);
    LAS unsigned char* L = F.lds; LAS float* bias2 = (LAS float*)(L + AT_BIAS);
    const int lane = F.lane, w = F.wave, q32 = lane & 31, hh = lane >> 5;
    const int n0 = cgi * 4, c = n0 + (w >> 1), qh = w & 1;
#ifdef APROBE
    unsigned long long aq[5] = {0, 0, 0, 0, 0}; unsigned long long at_ = __builtin_amdgcn_s_memrealtime(); const unsigned long long at0_ = at_;
#define AQ(k) do { const unsigned long long n_ = __builtin_amdgcn_s_memrealtime(); aq[k] += n_ - at_; at_ = n_; } while (0)
#else
#define AQ(k) do {} while (0)
#endif
    __syncthreads();
    if (F.tid < NREL) bias2[NREL - 1 - F.tid] = p.rel_bias[((size_t)l * NH + h) * NREL + F.tid] * LOG2E;
    const int tq = c * 64 + qh * 32 + q32; const size_t rq = (size_t)b * S + tq;
    f16x8 qf[4];
    { float qv[4][8]; float ss = 0.f;
#pragma unroll
      for (int s4 = 0; s4 < 4; ++s4) { const f16x8 v = *(const f16x8*)(PROJ + rq * NP + PC_Q + h * 64 + 16 * s4 + 8 * hh);
#pragma unroll
          for (int j = 0; j < 8; ++j) { qv[s4][j] = (float)v[j]; ss += qv[s4][j] * qv[s4][j]; } }
      ss = red_x32(ss);
      const float rs = rsqrtf(ss * (1.f / 64.f) + 1e-6f) * (0.125f * LOG2E);
#pragma unroll
      for (int s4 = 0; s4 < 4; ++s4) { const f32x4 g0 = *(const f32x4*)(p.qg + l * HD + 16 * s4 + 8 * hh), g1 = *(const f32x4*)(p.qg + l * HD + 16 * s4 + 8 * hh + 4);
          u32x4 wv; wv.x = pk_f16(qv[s4][0] * rs * g0[0], qv[s4][1] * rs * g0[1]); wv.y = pk_f16(qv[s4][2] * rs * g0[2], qv[s4][3] * rs * g0[3]);
          wv.z = pk_f16(qv[s4][4] * rs * g1[0], qv[s4][5] * rs * g1[1]); wv.w = pk_f16(qv[s4][6] * rs * g1[2], qv[s4][7] * rs * g1[3]);
          qf[s4] = __builtin_bit_cast(f16x8, wv); } }
    f32x16 O0, O1, cbv;
    { const float cb = p.rel_bias[((size_t)l * NH + h) * NREL + NREL - 1] * LOG2E;
#pragma unroll
      for (int r = 0; r < 16; ++r) { O0[r] = 0.f; O1[r] = 0.f; cbv[r] = cb; } }
    float lsum = 0.f;
    const int jlo = (n0 - 8 > 0) ? n0 - 8 : 0, jhi = n0 + 3;
    const int skey = F.tid >> 3, sch = F.tid & 7;
    const u16* kbase = PROJ + ((size_t)b * S + skey) * NP + PC_KA + h * 64 + sch * 8;
    const u16* vbase = PROJ + ((size_t)b * S + skey) * NP + PC_VA + h * 64 + sch * 8;
    const f32x4 kg0 = *(const f32x4*)(p.kg + l * HD + sch * 8), kg1 = *(const f32x4*)(p.kg + l * HD + sch * 8 + 4);
    u32x4 kreg = *(const u32x4*)(kbase + (size_t)jlo * 64 * NP), vreg = *(const u32x4*)(vbase + (size_t)jlo * 64 * NP);
    u32x4 kreg1 = kreg, vreg1 = vreg, kreg2 = kreg, vreg2 = vreg;
    if (jlo + 1 <= jhi) { kreg1 = *(const u32x4*)(kbase + (size_t)(jlo + 1) * 64 * NP); vreg1 = *(const u32x4*)(vbase + (size_t)(jlo + 1) * 64 * NP); }
    if (jlo + 2 <= jhi) { kreg2 = *(const u32x4*)(kbase + (size_t)(jlo + 2) * 64 * NP); vreg2 = *(const u32x4*)(vbase + (size_t)(jlo + 2) * 64 * NP); }
    const int ti = lane & 15, tg16 = (lane >> 4) & 1;
    const int vrow = (4 * hh + (ti >> 2)) * 128, vsw = ((ti >> 3) & 1) << 6, vcol = 32 * tg16 + 8 * (ti & 3);
    AQ(4);
    f32x16 st[2];
    auto sm_pv = [&](int vb) {
        const LAS unsigned char* Vb = L + AT_V + vb * 8192 + vrow;
        s16x4 vl0[4], vh0[4], vl1[4], vh1[4];
#pragma unroll
        for (int s4 = 0; s4 < 4; ++s4) { vl0[s4] = vtr(Vb + s4 * 2048 + ((vcol) ^ vsw)); vh0[s4] = vtr(Vb + s4 * 2048 + 1024 + ((vcol) ^ vsw));
            vl1[s4] = vtr(Vb + s4 * 2048 + ((64 + vcol) ^ vsw)); vh1[s4] = vtr(Vb + s4 * 2048 + 1024 + ((64 + vcol) ^ vsw)); }
        __builtin_amdgcn_sched_barrier(0);
#pragma unroll
        for (int kb = 0; kb < 2; ++kb)
#pragma unroll
            for (int r = 0; r < 16; ++r) { const float pv = __builtin_amdgcn_exp2f(st[kb][r]); lsum += pv; st[kb][r] = pv; }
#pragma unroll
        for (int s4 = 0; s4 < 4; ++s4) { const int kb = s4 >> 1, r0 = 8 * (s4 & 1);
            u32x4 pw; pw.x = pk_bf16(st[kb][r0 + 0], st[kb][r0 + 1]); pw.y = pk_bf16(st[kb][r0 + 2], st[kb][r0 + 3]); pw.z = pk_bf16(st[kb][r0 + 4], st[kb][r0 + 5]); pw.w = pk_bf16(st[kb][r0 + 6], st[kb][r0 + 7]);
            const bf16x8 pa = __builtin_bit_cast(bf16x8, pw);
            { const bf16x8 vf = {vl0[s4][0], vl0[s4][1], vl0[s4][2], vl0[s4][3], vh0[s4][0], vh0[s4][1], vh0[s4][2], vh0[s4][3]};
              O0 = __builtin_amdgcn_mfma_f32_32x32x16_bf16(vf, pa, O0, 0, 0, 0); }
            { const bf16x8 vf = {vl1[s4][0], vl1[s4][1], vl1[s4][2], vl1[s4][3], vh1[s4][0], vh1[s4][1], vh1[s4][2], vh1[s4][3]};
              O1 = __builtin_amdgcn_mfma_f32_32x32x16_bf16(vf, pa, O1, 0, 0, 0); } }
    };
    auto qk = [&](const f32x16& c0, const f32x16& c1, const LAS unsigned char* Kb) {
        f16x8 kf_[2][4];
#pragma unroll
        for (int kb = 0; kb < 2; ++kb)
#pragma unroll
            for (int s4 = 0; s4 < 4; ++s4) kf_[kb][s4] = *(const LAS f16x8*)(Kb + (32 * kb + q32) * 128 + (((2 * s4 + hh) ^ (q32 & 7)) * 16));
        __builtin_amdgcn_sched_barrier(0);
        st[0] = __builtin_amdgcn_mfma_f32_32x32x16_f16(kf_[0][0], qf[0], c0, 0, 0, 0);
        st[1] = __builtin_amdgcn_mfma_f32_32x32x16_f16(kf_[1][0], qf[0], c1, 0, 0, 0);
#pragma unroll
        for (int s4 = 1; s4 < 4; ++s4) { st[0] = __builtin_amdgcn_mfma_f32_32x32x16_f16(kf_[0][s4], qf[s4], st[0], 0, 0, 0); st[1] = __builtin_amdgcn_mfma_f32_32x32x16_f16(kf_[1][s4], qf[s4], st[1], 0, 0, 0); }
    };
    f16x4 gpre[2][4];
    auto trip = [&](const int j, const bool lastf) {
        asm volatile("s_waitcnt lgkmcnt(0)" ::: "memory"); AQ(2);
        const int buf = j & 1;
        {
            const f16x8 kv = __builtin_bit_cast(f16x8, kreg); float kf[8]; float ss = 0.f;
#pragma unroll
            for (int e = 0; e < 8; ++e) { kf[e] = (float)kv[e]; ss += kf[e] * kf[e]; }
            ss += __builtin_bit_cast(float, __builtin_amdgcn_update_dpp(0, __builtin_bit_cast(int, ss), 0xB1, 0xf, 0xf, true));
            ss += __builtin_bit_cast(float, __builtin_amdgcn_update_dpp(0, __builtin_bit_cast(int, ss), 0x4E, 0xf, 0xf, true));
            ss += __builtin_bit_cast(float, __builtin_amdgcn_update_dpp(0, __builtin_bit_cast(int, ss), 0x141, 0xf, 0xf, true));
            const float rs = rsqrtf(ss * (1.f / 64.f) + 1e-6f);
            u32x4 kw; kw.x = pk_f16(kf[0] * rs * kg0[0], kf[1] * rs * kg0[1]); kw.y = pk_f16(kf[2] * rs * kg0[2], kf[3] * rs * kg0[3]);
            kw.z = pk_f16(kf[4] * rs * kg1[0], kf[5] * rs * kg1[1]); kw.w = pk_f16(kf[6] * rs * kg1[2], kf[7] * rs * kg1[3]);
            *(LAS u32x4*)(L + AT_K + buf * 8192 + skey * 128 + ((sch ^ (skey & 7)) * 16)) = kw;
            const f16x8 vv = __builtin_bit_cast(f16x8, vreg);
            u32x4 vw; vw.x = pk_bf16((float)vv[0], (float)vv[1]); vw.y = pk_bf16((float)vv[2], (float)vv[3]); vw.z = pk_bf16((float)vv[4], (float)vv[5]); vw.w = pk_bf16((float)vv[6], (float)vv[7]);
            *(LAS u32x4*)(L + AT_V + buf * 8192 + skey * 128 + ((sch * 16) ^ (((skey >> 1) & 1) << 6))) = vw;
        }
        kreg = kreg1; vreg = vreg1; kreg1 = kreg2; vreg1 = vreg2;
        if (j + 3 <= jhi) { kreg2 = *(const u32x4*)(kbase + (size_t)(j + 3) * 64 * NP); vreg2 = *(const u32x4*)(vbase + (size_t)(j + 3) * 64 * NP); }
        if (lastf) {
#pragma unroll
            for (int db = 0; db < 2; ++db)
#pragma unroll
                for (int r4 = 0; r4 < 4; ++r4) gpre[db][r4] = *(const f16x4*)(PROJ + rq * NP + PC_GA + h * 64 + 32 * db + 8 * r4 + 4 * hh); }
        asm volatile("s_waitcnt lgkmcnt(0)" ::: "memory"); AQ(0); __syncthreads(); AQ(1);
        if (j >= c - 8 && j <= c) {
            const int dc = c - j;
            const LAS unsigned char* Kb = L + AT_K + buf * 8192;
            if (dc >= 3) qk(cbv, cbv, Kb);
            else { f32x16 bi[2];
                if (dc < 2) {
                    const LAS float* br = bias2 + (NREL - 1) - (64 * dc + 32 * qh + q32 + 63 - 4 * hh);
#pragma unroll
                    for (int kb = 0; kb < 2; ++kb)
#pragma unroll
                        for (int r = 0; r < 16; ++r) bi[kb][r] = br[32 * kb + (r & 3) + 8 * (r >> 2)]; }
                else {
#pragma unroll
                    for (int kb = 0; kb < 2; ++kb)
#pragma unroll
                        for (int r = 0; r < 16; ++r) { const int keyloc = 32 * kb + (r & 3) + 8 * (r >> 2) + 4 * hh; int dist = 64 * dc + (32 * qh + q32) - keyloc; dist = dist > 128 ? 128 : dist; bi[kb][r] = bias2[128 - dist]; } }
                qk(bi[0], bi[1], Kb); }
            sm_pv(buf);
        }
    };
#pragma unroll 1
    for (int j = jlo; j < jhi; ++j) trip(j, false);
    trip(jhi, true);
    asm volatile("s_waitcnt lgkmcnt(0)" ::: "memory"); AQ(2);
    lsum = red_x32(lsum);
    const float inv = 1.f / lsum;
#pragma unroll
    for (int db = 0; db < 2; ++db)
#pragma unroll
        for (int r4 = 0; r4 < 4; ++r4) { const int d0 = 32 * db + 8 * r4 + 4 * hh;
            const f16x4 gq = gpre[db][r4];
            const float g0 = (float)gq[0], g1 = (float)gq[1], g2 = (float)gq[2], g3 = (float)gq[3];
            const float o0 = (db ? O1[4 * r4 + 0] : O0[4 * r4 + 0]) * inv, o1 = (db ? O1[4 * r4 + 1] : O0[4 * r4 + 1]) * inv, o2 = (db ? O1[4 * r4 + 2] : O0[4 * r4 + 2]) * inv, o3 = (db ? O1[4 * r4 + 3] : O0[4 * r4 + 3]) * inv;
            u32x2 ow; ow.x = pk_f16(o0 * g0 * sigmoidf_(g0), o1 * g1 * sigmoidf_(g1)); ow.y = pk_f16(o2 * g2 * sigmoidf_(g2), o3 * g3 * sigmoidf_(g3));
#ifdef FORCE_O1
            ow.x = pk_f16(g0, g1); ow.y = pk_f16(g2, g3);
#endif
#ifdef FORCE_CONST
            ow.x = pk_f16(0.25f, 0.25f); ow.y = ow.x;
#endif
            *(u32x2*)(YO + rq * D + DR + h * 64 + d0) = ow; }
#ifdef APROBE
    if (l == 2 && F.bid == 71 && w == 0 && lane == 0 && (b * 64 + h * 8 + cgi) == 7) {
        const float us = 0.01f * (float)(APROBE == 3 ? (__builtin_amdgcn_s_memrealtime() - at0_) : aq[APROBE]);
        *((float*)(p.ws + WS_CTL) + 1024) = 100.f * exp2f(0.25f * rintf(4.f * log2f(fmaxf(us, 0.01f)))); }
#endif
}


typedef _Float16 f16x4_t __attribute__((ext_vector_type(4)));
constexpr int RW_PITCH = 136;
constexpr int RW_W2T = 0, RW_A2T = 9216, RW_SLOT0 = 18432, RW_SLOT = 12800, RW_SCR0 = RW_SLOT0 + 8 * RW_SLOT, RW_SCR = 2176, RW_CONST = RW_SCR0 + 8 * RW_SCR;
constexpr int SL_WT = 0, SL_RH = 2176, SL_BB = 4352, SL_KB = 6528, SL_VV = 8704, SL_MUKT = 10880, SL_ARBT = 11392, SL_ARKT = 11904, SL_GAM = 12416, SL_BD = 12672;
enum { RC_MUR = 0, RC_MUK, RC_MUV, RC_MUG, RC_W0, RC_A0, RC_KK, RC_KA, RC_RK, RC_LG, RC_LB, RC_MUWD, RC_MUAD };
constexpr int RW_CONSTH = RW_CONST + 13 * 256;
static_assert(RW_CONSTH + 6 * 128 <= LDS_MISC, "rwkv LDS map");
static_assert(RW_SLOT0 + 8 * 10240 <= RW_SCR0 && IMG_BYTES <= 10240, "P2a image staging");
static_assert(LDS_SVT + P1_MAXU * 1024 <= LDS_MISC, "in-proj table LDS map");

__device__ __forceinline__ f32x4 mfma16(f16x4_t a, f16x4_t b, f32x4 c) { return __builtin_amdgcn_mfma_f32_16x16x16f16(a, b, c, 0, 0, 0); }
__device__ __forceinline__ f32x4 mfma32h(f16x8 a, f16x8 b, f32x4 c) { return __builtin_amdgcn_mfma_f32_16x16x32_f16(a, b, c, 0, 0, 0); }
__device__ __forceinline__ f16x4_t cvt4(f32x4 v) { u32x2 w; w.x = pk_f16(v[0], v[1]); w.y = pk_f16(v[2], v[3]); return __builtin_bit_cast(f16x4_t, w); }
__device__ __forceinline__ f16x8 cat8(f16x4_t a, f16x4_t b) { return (f16x8){a[0], a[1], a[2], a[3], b[0], b[1], b[2], b[3]}; }
__device__ __forceinline__ f16x4_t trr4(const LAS unsigned char* p) { return __builtin_bit_cast(f16x4_t, __builtin_amdgcn_ds_read_tr16_b64_v4i16((LAS s16x4*)p)); }
__device__ __forceinline__ f32x4 cf4(f16x4_t v) { return (f32x4){(float)v[0], (float)v[1], (float)v[2], (float)v[3]}; }
__device__ __forceinline__ float frcp(float x) { return __builtin_amdgcn_rcpf(x); }
__device__ __forceinline__ float fsig(float x) { return frcp(1.f + __expf(-x)); }
#define DPP_SHR(x, n, fillbits) __builtin_bit_cast(float, __builtin_amdgcn_update_dpp((int)(fillbits), __builtin_bit_cast(int, (x)), 0x110 + (n), 0xf, 0xf, false))

struct PreRegs { f16x4_t rc[4], kc[4]; f16x8 wc[2], ac[2]; };
struct CarryRegs { f16x4_t rp[4], kp[4]; f16x8 wp[2], ap[2]; };
__device__ __forceinline__ void rwkv_pre_load(Frame& F, CP& p, int b, int h, int ch, PreRegs& R) {
    const u16* PROJ = (const u16*)(p.ws + WS_PROJ);
    const int lane = F.lane, t = lane & 15, g4 = lane >> 4;
    const u16* pr = PROJ + ((size_t)b * S + ch * 16 + t) * NP;
#pragma unroll
    for (int jt = 0; jt < 4; ++jt) { const int col = h * 64 + 16 * jt + 4 * g4; R.rc[jt] = *(const f16x4_t*)(pr + PC_R + col); R.kc[jt] = *(const f16x4_t*)(pr + PC_K + col); }
#pragma unroll
    for (int ks = 0; ks < 2; ++ks) { const int cj = 32 * ks + 8 * g4; R.wc[ks] = *(const f16x8*)(pr + PC_WD + cj); R.ac[ks] = *(const f16x8*)(pr + PC_AD + cj); }
}
__device__ __forceinline__ void rwkv_carry_load(Frame& F, CP& p, int b, int h, int ch, CarryRegs& Cr) {
    const u16* PROJ = (const u16*)(p.ws + WS_PROJ);
    const int g4 = F.lane >> 4;
    const f16x4_t z4 = {(_Float16)0.f, (_Float16)0.f, (_Float16)0.f, (_Float16)0.f};
    f16x8 z8;
#pragma unroll
    for (int e = 0; e < 8; ++e) z8[e] = (_Float16)0.f;
    const bool hp = ch > 0;
    const u16* pr = PROJ + ((size_t)b * S + (hp ? ch * 16 - 1 : 0)) * NP;
#pragma unroll
    for (int jt = 0; jt < 4; ++jt) { const int col = h * 64 + 16 * jt + 4 * g4; Cr.rp[jt] = hp ? *(const f16x4_t*)(pr + PC_R + col) : z4; Cr.kp[jt] = hp ? *(const f16x4_t*)(pr + PC_K + col) : z4; }
#pragma unroll
    for (int ks = 0; ks < 2; ++ks) { const int cj = 32 * ks + 8 * g4; Cr.wp[ks] = hp ? *(const f16x8*)(pr + PC_WD + cj) : z8; Cr.ap[ks] = hp ? *(const f16x8*)(pr + PC_AD + cj) : z8; }
}
struct VGRegs { f16x4_t vc[4], gc[4]; };
struct VGCarry { f16x4_t vp[4], gp[4]; };
struct ImgRegs { u32x4 q[10]; };
__device__ __forceinline__ void rwkv_vg_load(Frame& F, CP& p, int b, int h, int ch, VGRegs& V) {
    const u16* PROJ = (const u16*)(p.ws + WS_PROJ);
    const int lane = F.lane, t = lane & 15, g4 = lane >> 4;
    const u16* pr = PROJ + ((size_t)b * S + ch * 16 + t) * NP;
#pragma unroll
    for (int it = 0; it < 4; ++it) { const int col = h * 64 + 16 * it + 4 * g4; V.vc[it] = *(const f16x4_t*)(pr + PC_V + col); V.gc[it] = *(const f16x4_t*)(pr + PC_G + col); }
}
__device__ __forceinline__ void rwkv_vg_carry(Frame& F, CP& p, int b, int h, int ch, VGCarry& C) {
    const u16* PROJ = (const u16*)(p.ws + WS_PROJ);
    const int g4 = F.lane >> 4; const bool hp = ch > 0;
    const f16x4_t z4 = {(_Float16)0.f, (_Float16)0.f, (_Float16)0.f, (_Float16)0.f};
    const u16* pr = PROJ + ((size_t)b * S + (hp ? ch * 16 - 1 : 0)) * NP;
#pragma unroll
    for (int it = 0; it < 4; ++it) { const int col = h * 64 + 16 * it + 4 * g4; C.vp[it] = hp ? *(const f16x4_t*)(pr + PC_V + col) : z4; C.gp[it] = hp ? *(const f16x4_t*)(pr + PC_G + col) : z4; }
}
__device__ __forceinline__ void img_load(const unsigned char* img, ImgRegs& I, int lane) {
    const unsigned char* q0 = img + lane * 16;
#pragma unroll
    for (int i = 0; i < 9; ++i) I.q[i] = __builtin_nontemporal_load((const u32x4*)(q0 + i * 1024));
    I.q[9] = (lane < IMG_BYTES / 16 - 576) ? __builtin_nontemporal_load((const u32x4*)(q0 + 9 * 1024)) : (u32x4){0u, 0u, 0u, 0u};
}
struct ImgOffs { int o[10]; };
__device__ __forceinline__ void img_offs(ImgOffs& Of, int lane) {
#pragma unroll
    for (int i = 0; i < 10; ++i) { const int pc = lane + 64 * i; Of.o[i] = pc < 512 ? ((pc >> 7) * 2176 + ((pc >> 3) & 15) * RW_PITCH + (pc & 7) * 16) : (SL_MUKT + (pc - 512) * 16); }
}
__device__ __forceinline__ void img_to_slot2(LAS unsigned char* slot, const ImgRegs& I, const ImgOffs& Of, int lane) {
#pragma unroll
    for (int i = 0; i < 10; ++i) { if (i < 9 || lane < IMG_BYTES / 16 - 576) {
            u32x2 lo, hi; lo.x = I.q[i].x; lo.y = I.q[i].y; hi.x = I.q[i].z; hi.y = I.q[i].w;
            *(LAS u32x2*)(slot + Of.o[i]) = lo; *(LAS u32x2*)(slot + Of.o[i] + 8) = hi; } }
}
__device__ __forceinline__ void img_to_slot(LAS unsigned char* slot, const ImgRegs& I, int lane) {
#pragma unroll
    for (int i = 0; i < 10; ++i) { const int pc = lane + 64 * i;
        if (pc < IMG_BYTES / 16) { const int off = pc < 512 ? ((pc >> 7) * 2176 + ((pc >> 3) & 15) * RW_PITCH + (pc & 7) * 16) : (SL_MUKT + (pc - 512) * 16);
            u32x2 lo, hi; lo.x = I.q[i].x; lo.y = I.q[i].y; hi.x = I.q[i].z; hi.y = I.q[i].w;
            *(LAS u32x2*)(slot + off) = lo; *(LAS u32x2*)(slot + off + 8) = hi; } }
}
__device__ __forceinline__ f16x4_t prev4(f16x4_t cur, f16x4_t carry) {
    const u32x2 c = __builtin_bit_cast(u32x2, cur), k = __builtin_bit_cast(u32x2, carry); u32x2 r;
    r.x = (unsigned)__builtin_amdgcn_update_dpp((int)k.x, (int)c.x, 0x111, 0xf, 0xf, false); r.y = (unsigned)__builtin_amdgcn_update_dpp((int)k.y, (int)c.y, 0x111, 0xf, 0xf, false);
    return __builtin_bit_cast(f16x4_t, r);
}
__device__ __forceinline__ f16x8 prev8(f16x8 cur, f16x8 carry) {
    const u32x4 c = __builtin_bit_cast(u32x4, cur), k = __builtin_bit_cast(u32x4, carry); u32x4 r;
    r.x = (unsigned)__builtin_amdgcn_update_dpp((int)k.x, (int)c.x, 0x111, 0xf, 0xf, false); r.y = (unsigned)__builtin_amdgcn_update_dpp((int)k.y, (int)c.y, 0x111, 0xf, 0xf, false);
    r.z = (unsigned)__builtin_amdgcn_update_dpp((int)k.z, (int)c.z, 0x111, 0xf, 0xf, false); r.w = (unsigned)__builtin_amdgcn_update_dpp((int)k.w, (int)c.w, 0x111, 0xf, 0xf, false);
    return __builtin_bit_cast(f16x8, r);
}
__device__ __forceinline__ void rwkv_pre(Frame& F, CP& p, int b, int h, int ch, const PreRegs& R, const CarryRegs& Cr, LAS unsigned char* img  , LAS unsigned char* scr) {
    const LAS unsigned char* L = F.lds; const LAS float* RC = (const LAS float*)(L + RW_CONST);
    const int lane = F.lane, t = lane & 15, g4 = lane >> 4;
    float r_[4][4], k_[4][4];
    const LAS unsigned char* RH_ = L + RW_CONSTH;
#pragma unroll
    for (int jt = 0; jt < 4; ++jt) { const int cj = 16 * jt + 4 * g4;
        const f16x4_t mr = *(const LAS f16x4_t*)(RH_ + 0 * 128 + cj * 2), mk = *(const LAS f16x4_t*)(RH_ + 1 * 128 + cj * 2);
        const f16x4_t rs = R.rc[jt] + mr * (prev4(R.rc[jt], Cr.rp[jt]) - R.rc[jt]), ks = R.kc[jt] + mk * (prev4(R.kc[jt], Cr.kp[jt]) - R.kc[jt]);
#pragma unroll
        for (int e = 0; e < 4; ++e) { r_[jt][e] = (float)rs[e]; k_[jt][e] = (float)ks[e]; } }
    f16x8 twd[2], adf[2];
#pragma unroll
    for (int ks = 0; ks < 2; ++ks) { const int cj = 32 * ks + 8 * g4;
        const f16x8 mw = *(const LAS f16x8*)(RH_ + 4 * 128 + cj * 2), ma = *(const LAS f16x8*)(RH_ + 5 * 128 + cj * 2);
        const f16x8 wsh = R.wc[ks] + mw * (prev8(R.wc[ks], Cr.wp[ks]) - R.wc[ks]);
        adf[ks] = R.ac[ks] + ma * (prev8(R.ac[ks], Cr.ap[ks]) - R.ac[ks]);
        float wv[8];
#pragma unroll
        for (int q = 0; q < 8; ++q) { const float ex = __expf(2.f * (float)wsh[q]); wv[q] = 1.f - 2.f * frcp(ex + 1.f); }
        u32x4 tw; tw.x = pk_f16(wv[0], wv[1]); tw.y = pk_f16(wv[2], wv[3]); tw.z = pk_f16(wv[4], wv[5]); tw.w = pk_f16(wv[6], wv[7]);
        twd[ks] = __builtin_bit_cast(f16x8, tw); }
    float lw_[4][4], al_[4][4];
#pragma unroll
    for (int ct = 0; ct < 4; ++ct) { f32x4 aw = {0.f, 0.f, 0.f, 0.f}, aa = aw;
#pragma unroll
        for (int ks = 0; ks < 2; ++ks) { const int off = (16 * ct + t) * 144 + (32 * ks + 8 * g4) * 2;
            aw = mfma32h(*(const LAS f16x8*)(L + RW_W2T + off), twd[ks], aw); aa = mfma32h(*(const LAS f16x8*)(L + RW_A2T + off), adf[ks], aa); }
        const int cj = 16 * ct + 4 * g4;
        const f32x4 w0v = *(const LAS f32x4*)(RC + RC_W0 * 64 + cj), a0v = *(const LAS f32x4*)(RC + RC_A0 * 64 + cj);
#pragma unroll
        for (int e = 0; e < 4; ++e) { lw_[ct][e] = -0.6065306597126334f * fsig(w0v[e] + aw[e]); al_[ct][e] = fsig(a0v[e] + aa[e]); } }
    float kk_[4][4], k2_[4][4]; float ss = 0.f, bd = 0.f;
#pragma unroll
    for (int jt = 0; jt < 4; ++jt) { const int cj = 16 * jt + 4 * g4;
        const f32x4 kkv = *(const LAS f32x4*)(RC + RC_KK * 64 + cj), kav = *(const LAS f32x4*)(RC + RC_KA * 64 + cj), rkv = *(const LAS f32x4*)(RC + RC_RK * 64 + cj);
#pragma unroll
        for (int e = 0; e < 4; ++e) { const float kk = k_[jt][e] * kkv[e]; kk_[jt][e] = kk; ss += kk * kk;
            const float k2 = k_[jt][e] * (1.f + (al_[jt][e] - 1.f) * kav[e]); k2_[jt][e] = k2; bd += r_[jt][e] * k2 * rkv[e]; } }
    ss = red_rows(ss); bd = red_rows(bd);
    const float rn = 1.f / fmaxf(sqrtf(ss), 1e-12f);
    if (g4 == 0) ((float*)(p.ws + WS_BDG))[((size_t)b * S + ch * 16 + t) * 8 + h] = bd;
    f16x4_t Ahp[4], Rhp[4], Bcp[4], Kcp[4];
    float E1_[4][4], gam_[4][4];
#pragma unroll
    for (int jt = 0; jt < 4; ++jt)
#pragma unroll
        for (int e = 0; e < 4; ++e) { float G = lw_[jt][e];
            G += DPP_SHR(G, 1, 0); G += DPP_SHR(G, 2, 0); G += DPP_SHR(G, 4, 0); G += DPP_SHR(G, 8, 0);
            E1_[jt][e] = __expf(G); }
#pragma unroll
    for (int jt = 0; jt < 4; ++jt)
#pragma unroll
        for (int e = 0; e < 4; ++e) gam_[jt][e] = __builtin_bit_cast(float, __builtin_amdgcn_ds_bpermute(((lane & 48) | 15) << 2, __builtin_bit_cast(int, E1_[jt][e])));
#pragma unroll
    for (int jt = 0; jt < 4; ++jt) { f32x4 ah, rh, bc, kc, bb, kb, gm;
#pragma unroll
        for (int e = 0; e < 4; ++e) { const float E1 = E1_[jt][e]; const float E0 = DPP_SHR(E1, 1, 0x3f800000); const float Ei = frcp(E1);
            const float gam = gam_[jt][e];
            const float E2 = gam * Ei; const float a = -kk_[jt][e] * rn, bq = -a * al_[jt][e];
            ah[e] = a * E0; rh[e] = r_[jt][e] * E1; bc[e] = bq * Ei; kc[e] = k2_[jt][e] * Ei; bb[e] = bq * E2; kb[e] = k2_[jt][e] * E2; gm[e] = gam; }
        Ahp[jt] = cvt4(ah); Rhp[jt] = cvt4(rh); Bcp[jt] = cvt4(bc); Kcp[jt] = cvt4(kc);
        const int o = t * RW_PITCH + (16 * jt + 4 * g4) * 2, og = t * 128 + (16 * jt + 4 * g4) * 2;
        *(LAS f16x4_t*)(scr + o) = Ahp[jt]; *(LAS f16x4_t*)(img + IM_RH + og) = Rhp[jt]; *(LAS f16x4_t*)(img + IM_BB + og) = cvt4(bb); *(LAS f16x4_t*)(img + IM_KB + og) = cvt4(kb);
        if (t == 15) *(LAS f32x4*)(img + IM_GAM + (16 * jt + 4 * g4) * 4) = gm; }
    const f32x4 Z = {0.f, 0.f, 0.f, 0.f};
    f32x4 Aab = Z, AabT = Z, Aak = Z, ArbT = Z, ArkT = Z;
#pragma unroll
    for (int ks = 0; ks < 2; ++ks) { const f16x8 ah = cat8(Ahp[2 * ks], Ahp[2 * ks + 1]), rh = cat8(Rhp[2 * ks], Rhp[2 * ks + 1]), bc = cat8(Bcp[2 * ks], Bcp[2 * ks + 1]), kc = cat8(Kcp[2 * ks], Kcp[2 * ks + 1]);
        Aab = mfma32h(ah, bc, Aab); AabT = mfma32h(bc, ah, AabT); Aak = mfma32h(ah, kc, Aak); ArbT = mfma32h(bc, rh, ArbT); ArkT = mfma32h(kc, rh, ArkT); }
    f32x4 Q;
#pragma unroll
    for (int rr = 0; rr < 4; ++rr) { const int row4 = 4 * g4 + rr;
        Aab[rr] = (t < row4) ? Aab[rr] : 0.f; Aak[rr] = (t < row4) ? Aak[rr] : 0.f;
        AabT[rr] = (row4 < t) ? AabT[rr] : 0.f;
        ArbT[rr] = (row4 <= t) ? ArbT[rr] : 0.f; ArkT[rr] = (row4 <= t) ? ArkT[rr] : 0.f;
        Q[rr] = AabT[rr] + ((row4 == t) ? 1.f : 0.f); }
    const f16x4_t x = cvt4(Aab), xt = cvt4(AabT);
    const f32x4 A2 = mfma16(xt, x, Z), A2t = mfma16(x, xt, Z);
    const f16x4_t a2 = cvt4(A2), a2t = cvt4(A2t);
    const f32x4 A4 = mfma16(a2t, a2, Z), A4t = mfma16(a2, a2t, Z);
    const f16x4_t a4 = cvt4(A4), a4t = cvt4(A4t);
    const f32x4 A8 = mfma16(a4t, a4, Z);
    Q = mfma16(a2, cvt4(Q), Q); Q = mfma16(a4, cvt4(Q), Q); Q = mfma16(cvt4(A8), cvt4(Q), Q);
    const f16x4_t tt = cvt4(Q);
    const int tro = (4 * g4 + (t >> 2)) * RW_PITCH + 8 * (t & 3);
#pragma unroll
    for (int jt = 0; jt < 4; ++jt) { const f32x4 wt = mfma16(trr4(scr + tro + 32 * jt), tt, Z);
        *(LAS f16x4_t*)(img + IM_WT + t * 128 + (16 * jt + 4 * g4) * 2) = cvt4(wt); }
    *(LAS f16x4_t*)(img + IM_MUKT + lane * 8) = cvt4(mfma16(cvt4(Aak), tt, Z));
    *(LAS f16x4_t*)(img + IM_ARBT + lane * 8) = cvt4(ArbT);
    *(LAS f16x4_t*)(img + IM_ARKT + lane * 8) = cvt4(ArkT);
}

struct ChainOps { f16x4_t wt[4], rh[4], mukt, arbt, arkt, vf, bbt[4], kbt[4]; f32x4 gm[4]; };
__device__ __forceinline__ void chain_ops_load(ChainOps& O, const LAS unsigned char* slot, int it, int tro, int l1o, int lane, int g4) {
#pragma unroll
    for (int jt = 0; jt < 4; ++jt) { O.wt[jt] = *(const LAS f16x4_t*)(slot + SL_WT + l1o + 32 * jt); O.rh[jt] = *(const LAS f16x4_t*)(slot + SL_RH + l1o + 32 * jt);
        O.bbt[jt] = trr4(slot + SL_BB + tro + 32 * jt); O.kbt[jt] = trr4(slot + SL_KB + tro + 32 * jt); O.gm[jt] = *(const LAS f32x4*)(slot + SL_GAM + (16 * jt + 4 * g4) * 4); }
    O.mukt = *(const LAS f16x4_t*)(slot + SL_MUKT + lane * 8); O.arbt = *(const LAS f16x4_t*)(slot + SL_ARBT + lane * 8); O.arkt = *(const LAS f16x4_t*)(slot + SL_ARKT + lane * 8);
    O.vf = trr4(slot + SL_VV + tro + 32 * it);
}
template <int NC> __device__ __forceinline__ void rwkv_chainN(Frame& F, f32x4 (&st)[4], const LAS unsigned char* slot0, u16* yrow0, int it) {
    const int lane = F.lane, t = lane & 15, g4 = lane >> 4;
    const f32x4 Z = {0.f, 0.f, 0.f, 0.f};
    const int tro = (4 * g4 + (t >> 2)) * RW_PITCH + 8 * (t & 3), l1o = t * RW_PITCH + 8 * g4;
    ChainOps O; chain_ops_load(O, slot0, it, tro, l1o, lane, g4);
#pragma unroll
    for (int cc = 0; cc < NC; ++cc) {
        ChainOps N;
        if (cc + 1 < NC) chain_ops_load(N, slot0 + (cc + 1) * RW_SLOT, it, tro, l1o, lane, g4); else N = O;
        const f16x8 sb0 = cat8(cvt4(st[0]), cvt4(st[1])), sb1 = cat8(cvt4(st[2]), cvt4(st[3]));
        f32x4 U = mfma16(O.mukt, O.vf, Z);
        U = mfma32h(cat8(O.wt[0], O.wt[1]), sb0, U); U = mfma32h(cat8(O.wt[2], O.wt[3]), sb1, U);
        const f16x4_t uf = cvt4(U); const f16x8 uv = cat8(uf, O.vf);
#pragma unroll
        for (int jt = 0; jt < 4; ++jt) st[jt] = mfma32h(cat8(O.bbt[jt], O.kbt[jt]), uv, st[jt] * O.gm[jt]);
        f32x4 Y = mfma32h(sb0, cat8(O.rh[0], O.rh[1]), Z); Y = mfma32h(sb1, cat8(O.rh[2], O.rh[3]), Y);
        Y = mfma32h(uv, cat8(O.arbt, O.arkt), Y);
        *(f16x4_t*)(yrow0 + (size_t)(cc * 16 + t) * D + 16 * it + 4 * g4) = cvt4(Y);
        O = N;
        __builtin_amdgcn_sched_barrier(0);
    }
}

__device__ __forceinline__ void rwkv_vv_build(Frame& F, const VGRegs& V, const VGCarry& C, LAS unsigned char* slot) {
    const int lane = F.lane, t = lane & 15, g4 = lane >> 4;
#pragma unroll
    for (int it = 0; it < 4; ++it) { const int ci = 16 * it + 4 * g4;
        const f16x4_t mv = *(const LAS f16x4_t*)(F.lds + RW_CONSTH + 2 * 128 + ci * 2);
        *(LAS f16x4_t*)(slot + SL_VV + t * RW_PITCH + ci * 2) = V.vc[it] + mv * (prev4(V.vc[it], C.vp[it]) - V.vc[it]); }
}
__device__ __forceinline__ void rwkv_post(Frame& F, CP& p, int b, int h, int ch, const VGRegs& G, const VGCarry& Cr, const LAS unsigned char* slot, const LAS unsigned char* ybuf) {
    u16* YO = (u16*)(p.ws + WS_YB);
    const LAS float* RC = (const LAS float*)(F.lds + RW_CONST);
    const int lane = F.lane, t = lane & 15, g4 = lane >> 4;
    const size_t row = (size_t)b * S + ch * 16 + t;
    f32x4 y[4]; float s1 = 0.f;
#pragma unroll
    for (int it = 0; it < 4; ++it) { y[it] = cf4(*(const LAS f16x4_t*)(ybuf + t * RW_PITCH + (16 * it + 4 * g4) * 2)); s1 += (y[it][0] + y[it][1]) + (y[it][2] + y[it][3]); }
    s1 = red_rows(s1);
    const float mean = s1 * (1.f / 64.f); float s2 = 0.f;
#pragma unroll
    for (int it = 0; it < 4; ++it) { y[it] = y[it] - mean; s2 += (y[it][0] * y[it][0] + y[it][1] * y[it][1]) + (y[it][2] * y[it][2] + y[it][3] * y[it][3]); }
    s2 = red_rows(s2);
    const float rstd = rsqrtf(s2 * (1.f / 64.f) + 64e-5f);
    const float bd = *(const LAS float*)(slot + SL_BD + t * 4);
#pragma unroll
    for (int it = 0; it < 4; ++it) { const int ci = 16 * it + 4 * g4, col = h * 64 + ci;
        const f32x4 lg = *(const LAS f32x4*)(RC + RC_LG * 64 + ci), lb = *(const LAS f32x4*)(RC + RC_LB * 64 + ci);
        const f32x4 v = cf4(*(const LAS f16x4_t*)(slot + SL_VV + t * RW_PITCH + ci * 2));
        const f16x4_t mgh = *(const LAS f16x4_t*)(F.lds + RW_CONSTH + 3 * 128 + ci * 2);
        const f32x4 g = cf4(G.gc[it] + mgh * (prev4(G.gc[it], Cr.gp[it]) - G.gc[it]));
        f32x4 o;
#pragma unroll
        for (int e = 0; e < 4; ++e) { const float yn = y[it][e] * rstd * lg[e] + lb[e] + bd * v[e]; o[e] = yn * g[e] * fsig(g[e]); }
        *(f16x4_t*)(YO + row * D + col) = cvt4(o); }
}

__device__ __forceinline__ void rwkv_tables(Frame& F, CP& p, int l, int h, bool lora) {
    LAS unsigned char* L = F.lds; LAS float* RC = (LAS float*)(L + RW_CONST);
    for (int i = F.tid; i < 13 * 64; i += NTHR) { const int a = i >> 6, c = i & 63; float v;
        switch (a) { case RC_MUR: v = p.mu[l * DSH + PC_R + h * 64 + c]; break; case RC_MUK: v = p.mu[l * DSH + PC_K + h * 64 + c]; break; case RC_MUV: v = p.mu[l * DSH + PC_V + h * 64 + c]; break;
            case RC_MUG: v = p.mu[l * DSH + PC_G + h * 64 + c]; break; case RC_W0: v = p.w0[l * DR + h * 64 + c]; break; case RC_A0: v = p.a0[l * DR + h * 64 + c]; break;
            case RC_KK: v = p.k_k[l * DR + h * 64 + c]; break; case RC_KA: v = p.k_a[l * DR + h * 64 + c]; break; case RC_RK: v = p.r_k[l * DR + h * 64 + c]; break;
            case RC_LG: v = p.lnx_g[l * DR + h * 64 + c]; break; case RC_LB: v = p.lnx_b[l * DR + h * 64 + c]; break; case RC_MUWD: v = p.mu[l * DSH + PC_WD + c]; break; default: v = p.mu[l * DSH + PC_AD + c]; break; }
        RC[i] = v;
        if (a <= RC_MUG) ((LAS u16*)(L + RW_CONSTH))[a * 64 + c] = f2h(v); else if (a >= RC_MUWD) ((LAS u16*)(L + RW_CONSTH))[(4 + a - RC_MUWD) * 64 + c] = f2h(v); }
    if (lora) { const u16* w2t = (const u16*)(p.ws + WS_W2T) + ((size_t)l * DR + h * 64) * 64; const u16* a2t = (const u16*)(p.ws + WS_A2T) + ((size_t)l * DR + h * 64) * 64;
        const int c = F.tid >> 3, q = F.tid & 7;
        *(LAS u32x4*)(L + RW_W2T + c * 144 + q * 16) = *(const u32x4*)(w2t + c * 64 + q * 8); *(LAS u32x4*)(L + RW_A2T + c * 144 + q * 16) = *(const u32x4*)(a2t + c * 64 + q * 8); }
    __syncthreads();
}
__device__ __forceinline__ void p2a_rwkv_pre(Frame& F, CP& p, int l) {
    const int bh = (F.bid & 7) | (((F.bid >> 3) & 7) << 3), b = bh >> 3, h = bh & 7, c0 = (F.bid >> 6) * 32, w = F.wave;
    rwkv_tables(F, p, l, h, true);
    LAS unsigned char* scr = F.lds + RW_SCR0 + w * RW_SCR;
    LAS unsigned char* stg = F.lds + RW_SLOT0 + w * 10240;
    PreRegs R; rwkv_pre_load(F, p, b, h, c0 + w, R);
#pragma unroll 1
    for (int i = 0; i < 4; ++i) { const int ch = c0 + 8 * i + w;
        { int ln_ = F.lane; asm volatile("" : "+v"(ln_)); F.lane = ln_; }
        if (i == 2 && w >= 4) __builtin_amdgcn_s_setprio(1);
        CarryRegs Cr; rwkv_carry_load(F, p, b, h, ch, Cr);
        rwkv_pre(F, p, b, h, ch, R, Cr, stg, scr);
        { asm volatile("s_waitcnt lgkmcnt(0)" ::: "memory");
          unsigned char* gi = img_ptr(p.ws, bh * 128 + ch) + F.lane * 16; const LAS unsigned char* si = stg + F.lane * 16;
#pragma unroll
          for (int i = 0; i < 10; ++i) if (i < 9 || F.lane < IMG_BYTES / 16 - 576) st16_wt(gi + i * 1024, *(const LAS u32x4*)(si + i * 1024)); }
        if (i + 1 < 4) rwkv_pre_load(F, p, b, h, ch + 8, R); }
    __builtin_amdgcn_s_setprio(0);
}
struct HChunk { u32x4 q[10]; u32x2 v[4], c[4]; };
#define HC_LOADS 18
#define HL16(dst, ptr, off) asm volatile("global_load_dwordx4 %0, %1, off offset:" #off " nt" : "=v"(dst) : "v"(ptr))
#define HL8(dst, ptr, off) asm volatile("global_load_dwordx2 %0, %1, off offset:" #off : "=v"(dst) : "v"(ptr))
__device__ __forceinline__ void h_issue(HChunk& R, CP& p, int bh, int ch, int lane) {
    const unsigned char* q0 = img_ptr(p.ws, bh * 128 + ch) + lane * 16; const unsigned char* q1 = q0 + 4096; const unsigned char* q2 = q0 + 8192;
    const unsigned char* q3 = q0 + ((lane < IMG_BYTES / 16 - 576) ? 9216 : 8192);
    HL16(R.q[0], q0, 0); HL16(R.q[1], q0, 1024); HL16(R.q[2], q0, 2048); HL16(R.q[3], q0, 3072);
    HL16(R.q[4], q1, 0); HL16(R.q[5], q1, 1024); HL16(R.q[6], q1, 2048); HL16(R.q[7], q1, 3072);
    HL16(R.q[8], q2, 0); HL16(R.q[9], q3, 0);
    const int t = lane & 15, g4 = lane >> 4; const u16* PROJ = (const u16*)(p.ws + WS_PROJ);
    const u16* pv = PROJ + ((size_t)(bh >> 3) * S + ch * 16 + t) * NP + PC_V + (bh & 7) * 64 + 4 * g4;
    const u16* pc = PROJ + ((size_t)(bh >> 3) * S + (ch > 0 ? ch * 16 - 1 : 0)) * NP + PC_V + (bh & 7) * 64 + 4 * g4;
    HL8(R.v[0], pv, 0); HL8(R.v[1], pv, 32); HL8(R.v[2], pv, 64); HL8(R.v[3], pv, 96);
    HL8(R.c[0], pc, 0); HL8(R.c[1], pc, 32); HL8(R.c[2], pc, 64); HL8(R.c[3], pc, 96);
}
#define H_WAIT(R, N) asm volatile("s_waitcnt vmcnt(" #N ")" : "+v"(R.q[0]), "+v"(R.q[1]), "+v"(R.q[2]), "+v"(R.q[3]), "+v"(R.q[4]), "+v"(R.q[5]), "+v"(R.q[6]), "+v"(R.q[7]), "+v"(R.q[8]), "+v"(R.q[9]), \
        "+v"(R.v[0]), "+v"(R.v[1]), "+v"(R.v[2]), "+v"(R.v[3]), "+v"(R.c[0]), "+v"(R.c[1]), "+v"(R.c[2]), "+v"(R.c[3]) :: "memory")
__device__ __forceinline__ void h_store(Frame& F, const HChunk& R, LAS unsigned char* slot, bool hp, const f16x4_t (&mvr)[4]) {
    const int lane = F.lane, t = lane & 15, g4 = lane >> 4;
    LAS unsigned char* s0 = slot + (lane >> 3) * RW_PITCH + (lane & 7) * 16; LAS unsigned char* s1 = slot + SL_MUKT + lane * 16;
#pragma unroll
    for (int i = 0; i < 10; ++i) { if (i < 9 || lane < IMG_BYTES / 16 - 576) {
            u32x2 lo, hi; lo.x = R.q[i].x; lo.y = R.q[i].y; hi.x = R.q[i].z; hi.y = R.q[i].w;
            LAS unsigned char* d = i < 8 ? s0 + (i >> 1) * 2176 + (i & 1) * 8 * RW_PITCH : s1 + (i - 8) * 1024;
            *(LAS u32x2*)d = lo; *(LAS u32x2*)(d + 8) = hi; } }
    const f16x4_t z4 = {(_Float16)0.f, (_Float16)0.f, (_Float16)0.f, (_Float16)0.f};
#pragma unroll
    for (int it = 0; it < 4; ++it) { const int ci = 16 * it + 4 * g4;
        const f16x4_t vc = __builtin_bit_cast(f16x4_t, R.v[it]), vp = hp ? __builtin_bit_cast(f16x4_t, R.c[it]) : z4;
        *(LAS f16x4_t*)(slot + SL_VV + t * RW_PITCH + ci * 2) = vc + mvr[it] * (prev4(vc, vp) - vc); }
}

__device__ __forceinline__ void rwkv_unit_chain(Frame& F, CP& p, int l, int b, int h) {
    LAS unsigned char* L = F.lds;
#ifdef CPROBE
    unsigned long long cq[3] = {0, 0, 0}; unsigned long long ct_ = __builtin_amdgcn_s_memrealtime();
#define CQ(k) do { const unsigned long long n_ = __builtin_amdgcn_s_memrealtime(); cq[k] += n_ - ct_; ct_ = n_; } while (0)
#ifndef CPQ
#define CPQ 8.f
#endif
#ifndef CPOFF
#define CPOFF 0.f
#endif
#define CQ_OUT(wsel, k, id) do { if (CPROBE == (id) && l == 1 && F.bid == 0 && F.wave == (wsel) && F.lane == 0) { const float us = 0.01f * (float)cq[k]; *((float*)(p.ws + WS_CTL) + 1024) = 1.f + floorf((us + CPOFF) / CPQ); } } while (0)
#else
#define CQ(k) do {} while (0)
#define CQ_OUT(wsel, k, id) do {} while (0)
#endif
    rwkv_tables(F, p, l, h, false);
    const int w = F.wave, bh = b * 8 + h;
    constexpr int NIT = S / 64;
    volatile LAS unsigned* flg = (volatile LAS unsigned*)(F.lds + LDS_MISC + 128);
    if (F.tid < 4) flg[F.tid] = 0u;
    __syncthreads();
    if (w < 4) {
        f32x4 st[4];
#pragma unroll
        for (int jt = 0; jt < 4; ++jt) st[jt] = (f32x4){0.f, 0.f, 0.f, 0.f};
        u16* YO = (u16*)(p.ws + WS_YB) + (size_t)b * S * D + h * 64;
        __builtin_amdgcn_s_setprio(2);
#pragma unroll 1
        for (int i = 0; i < NIT; ++i) {
            { const unsigned need = 4u * (unsigned)((i >> 1) + 1); while (flg[i & 1] < need) __builtin_amdgcn_s_sleep(0); asm volatile("" ::: "memory"); }
            { int ln_ = F.lane; asm volatile("" : "+v"(ln_)); F.lane = ln_; }
#ifdef PROBE_CHAINSTEPX2
            { f32x4 sv_[4] = {st[0], st[1], st[2], st[3]}; rwkv_chainN<4>(F, st, L + RW_SLOT0 + (i & 1) * 4 * RW_SLOT, YO + (size_t)i * 64 * D, w); st[0] = sv_[0]; st[1] = sv_[1]; st[2] = sv_[2]; st[3] = sv_[3]; }
#endif
            rwkv_chainN<4>(F, st, L + RW_SLOT0 + (i & 1) * 4 * RW_SLOT, YO + (size_t)i * 64 * D, w);
            asm volatile("s_waitcnt lgkmcnt(0)" ::: "memory");
            if (F.lane == 0) __hip_atomic_fetch_add((LAS unsigned*)(F.lds + LDS_MISC + 128) + 2 + (i & 1), 1u, __ATOMIC_RELAXED, __HIP_MEMORY_SCOPE_WORKGROUP);
        }
        __builtin_amdgcn_s_setprio(0);
        CQ_OUT(0, 0, 1); CQ_OUT(0, 1, 2);
    } else {
        __builtin_amdgcn_s_setprio(0);
        const int q = (w - 4) >> 1, sub = (w - 4) & 1;
        HChunk A, B;
        f16x4_t mvr[4];
#pragma unroll
        for (int it = 0; it < 4; ++it) mvr[it] = *(const LAS f16x4_t*)(F.lds + RW_CONSTH + 2 * 128 + (16 * it + 4 * (F.lane >> 4)) * 2);
        LAS unsigned char* slotA = L + RW_SLOT0 + (q * 4 + 2 * sub) * RW_SLOT;
#pragma unroll 1
        for (int k = -1; k < NIT / 2; ++k) {
            const bool act = k >= 0; const int nt_ = 2 * k + 2 + q, ch = 4 * (nt_ < NIT ? nt_ : NIT - 1) + 2 * sub;
            if (act) {
                { const unsigned need = 4u * (unsigned)k; while (flg[2 + q] < need) __builtin_amdgcn_s_sleep(0); asm volatile("" ::: "memory"); }
                H_WAIT(A, 18); h_store(F, A, slotA, (k | q | sub) != 0, mvr);
                asm volatile("" ::: "memory");
                if (F.lane == 0) __hip_atomic_fetch_add((LAS unsigned*)(F.lds + LDS_MISC + 128) + q, 1u, __ATOMIC_RELAXED, __HIP_MEMORY_SCOPE_WORKGROUP);
            }
            h_issue(A, p, bh, ch, F.lane);
            if (act) { H_WAIT(B, 18); h_store(F, B, slotA + RW_SLOT, true, mvr); asm volatile("" ::: "memory");
                if (F.lane == 0) __hip_atomic_fetch_add((LAS unsigned*)(F.lds + LDS_MISC + 128) + q, 1u, __ATOMIC_RELAXED, __HIP_MEMORY_SCOPE_WORKGROUP); }
            h_issue(B, p, bh, ch + 1, F.lane);
        }
        H_WAIT(A, 0); H_WAIT(B, 0);
        __builtin_amdgcn_s_setprio(0);
        CQ_OUT(4, 0, 3); CQ_OUT(4, 1, 4); CQ_OUT(4, 2, 5);
    }
}

__device__ __forceinline__ void p2c_post(Frame& F, CP& p, int l) {
    const u16* PROJ = (const u16*)(p.ws + WS_PROJ); u16* YO = (u16*)(p.ws + WS_YB); const float* BDG = (const float*)(p.ws + WS_BDG);
    LAS float* TB = (LAS float*)F.lds;
    for (int i = F.tid; i < 4 * 512; i += NTHR) { const int a = i >> 9, c = i & 511;
        TB[i] = a == 0 ? p.lnx_g[l * DR + c] : a == 1 ? p.lnx_b[l * DR + c] : a == 2 ? p.mu[l * DSH + PC_V + c] : p.mu[l * DSH + PC_G + c]; }
    __syncthreads();
    const int lane = F.lane, head = lane >> 3, c0 = lane * 8;
    const int gw = F.bid * NWAVES + F.wave, NGW = F.G * NWAVES;
    const __amdgpu_buffer_rsrc_t yb_rsrc = __builtin_amdgcn_make_buffer_rsrc((void*)YO, (short)0, (int)((size_t)M * D * 2), 0x00020000);
    f16x8 nyv[2], nvc[2], ngc[2], nvp, ngp; float nbd[2] = {0.f, 0.f};
    auto load_item = [&](int pr) { const size_t row = (size_t)pr * 2; const bool hasprev = (row & (S - 1)) != 0;
        const u16* pj = PROJ + row * NP; const u16* pp = hasprev ? pj - NP : pj;
#pragma unroll
        for (int hf = 0; hf < 2; ++hf) { nyv[hf] = __builtin_nontemporal_load((const f16x8*)(YO + (row + hf) * D + c0)); nvc[hf] = *(const f16x8*)(pj + hf * NP + PC_V + c0); ngc[hf] = *(const f16x8*)(pj + hf * NP + PC_G + c0);
            nbd[hf] = BDG[(row + hf) * 8 + head]; }
        nvp = *(const f16x8*)(pp + PC_V + c0); ngp = *(const f16x8*)(pp + PC_G + c0); };
    if (gw < M / 2) load_item(gw);
#pragma unroll 1
    for (int pr = gw; pr < M / 2; pr += NGW) {
        const size_t row = (size_t)pr * 2; const bool hasprev = (row & (S - 1)) != 0;
        f16x8 yv[2], vc[2], gc[2], vp[2], gp[2]; float bd[2];
#pragma unroll
        for (int hf = 0; hf < 2; ++hf) { yv[hf] = nyv[hf]; vc[hf] = nvc[hf]; gc[hf] = ngc[hf]; bd[hf] = nbd[hf]; }
        vp[0] = nvp; gp[0] = ngp; vp[1] = vc[0]; gp[1] = gc[0];
        if (pr + NGW < M / 2) load_item(pr + NGW);
#pragma unroll
        for (int hf = 0; hf < 2; ++hf) { const float pm = (hf == 1 || hasprev) ? 1.f : 0.f;
            float y[8]; float s1 = 0.f;
#pragma unroll
            for (int e = 0; e < 8; ++e) { y[e] = (float)yv[hf][e]; s1 += y[e]; }
            s1 += __shfl_xor(s1, 1); s1 += __shfl_xor(s1, 2); s1 += __shfl_xor(s1, 4);
            const float mean = s1 * (1.f / 64.f); float s2 = 0.f;
#pragma unroll
            for (int e = 0; e < 8; ++e) { y[e] -= mean; s2 += y[e] * y[e]; }
            s2 += __shfl_xor(s2, 1); s2 += __shfl_xor(s2, 2); s2 += __shfl_xor(s2, 4);
            const float rstd = rsqrtf(s2 * (1.f / 64.f) + 64e-5f);
            u32x4 ow; unsigned pk[4];
#pragma unroll
            for (int e2 = 0; e2 < 4; ++e2) { float o2[2];
#pragma unroll
                for (int z = 0; z < 2; ++z) { const int e = 2 * e2 + z, c = c0 + e;
                    const float vcur = (float)vc[hf][e], gcur = (float)gc[hf][e];
                    const float v = vcur + TB[1024 + c] * ((float)vp[hf][e] * pm - vcur), g = gcur + TB[1536 + c] * ((float)gp[hf][e] * pm - gcur);
                    const float yn = y[e] * rstd * TB[c] + TB[512 + c] + bd[hf] * v; o2[z] = yn * g * fsig(g); }
                pk[e2] = pk_f16(o2[0], o2[1]); }
            ow.x = pk[0]; ow.y = pk[1]; ow.z = pk[2]; ow.w = pk[3];
            __builtin_amdgcn_raw_buffer_store_b128(ow, yb_rsrc, (int)((row + hf) * (D * 2) + c0 * 2), 0,   16); }
    }
}


__device__ __forceinline__ void p2_mixer(Frame& F, CP& p, int l) {
    if (F.G != 256) {
        if (F.bid < 64) rwkv_unit_chain(F, p, l, F.bid >> 3, F.bid & 7);
        else { for (int u = F.bid - 64; u < NB * NH * 8; u += F.G - 64) attn_wg_unit(F, p, l, u >> 6, (u >> 3) & 7, u & 7);
            if (l + 1 < NL && F.bid >= 192) { __syncthreads(); conv_weights_layer(F, p, l + 1, (F.bid - 192) * NWAVES + F.wave, (F.G - 192) * NWAVES, true, false); } }
        return; }
    constexpr int NATT = NB * NH * 8, NSTAT = 192, NCONV = 64;
    const int nitems = NATT + (l + 1 < NL ? NCONV : 0);
    unsigned* qh = (unsigned*)(p.ws + WS_CTL) + CW_Q + l * 64;
    volatile LAS int* qslot = (volatile LAS int*)(F.lds + LDS_MISC + 64);
    int mine = F.bid - 64;
    if (F.bid < 64) { rwkv_unit_chain(F, p, l, F.bid >> 3, F.bid & 7); if (F.tid == 0) mine = NSTAT + (int)xb_add(qh, 1u); }
#pragma unroll 1
    for (;;) {
        __syncthreads();
        if (F.tid == 0) *qslot = mine;
        __syncthreads();
        const int it = *qslot;
        if (it >= nitems) break;
        if (F.tid == 0) mine = NSTAT + (int)xb_add(qh, 1u);
        if (it < NATT) { int bh, cg; if (it < 384) { bh = it / 6; cg = 2 + it % 6; } else { bh = it & 63; cg = it < 448 ? 1 : 0; }
            attn_wg_unit(F, p, l, bh >> 3, bh & 7, cg); }
        else conv_weights_layer(F, p, l + 1, (it - NATT) * NWAVES + F.wave, NCONV * NWAVES, true, false);
    }
}

__global__ void __launch_bounds__(NTHR, 2) mk_fwd(Params p_) {
    extern __shared__ __attribute__((aligned(16))) unsigned char lds_raw[];
    Frame F; F.lds = (LAS unsigned char*)lds_raw; F.tid = threadIdx.x; F.lane = F.tid & 63; F.wave = __builtin_amdgcn_readfirstlane(F.tid >> 6); F.G = gridDim.x; F.bid = blockIdx.x;
    const int lo = p_.ph_lo, hi = p_.ph_hi;
    int ph = 0;
    volatile LAS unsigned* MISC = (volatile LAS unsigned*)(F.lds + LDS_MISC);
    if (threadIdx.x < 16) MISC[threadIdx.x] = 0u;
    __syncthreads();
    XcdBarrier xbar = xcd_barrier_post((unsigned*)(p_.ws + WS_CTL) + CW_BAR, MISC + 8);
#ifdef TIMING
    unsigned long long tspan[8] = {0,0,0,0,0,0,0,0}; unsigned long long tlast = __builtin_amdgcn_s_memrealtime();
#define TSTAMP(k) do { const unsigned long long now_ = __builtin_amdgcn_s_memrealtime(); tspan[k] += now_ - tlast; tlast = now_; } while (0)
#else
#define TSTAMP(k) do {} while (0)
#endif
#ifdef SPROBE
    float spe_ = 0.f; unsigned long long sp0_ = 0;
#define SP_BEG(id, blk) do { if (SPROBE == (id) && l == 1 && F.bid == (blk)) sp0_ = __builtin_amdgcn_s_memrealtime(); } while (0)
#define SP_END(id, blk) do { if (SPROBE == (id) && l == 1 && F.bid == (blk)) { const float us = 0.01f * (float)(__builtin_amdgcn_s_memrealtime() - sp0_); spe_ = 100.f * exp2f(0.25f * rintf(4.f * log2f(fmaxf(us, 0.01f)))); } } while (0)
#else
#define SP_BEG(id, blk) do {} while (0)
#define SP_END(id, blk) do {} while (0)
#endif
#ifdef GPROBE
    float gpe_ = 0.f; unsigned long long gp0_ = 0; int gpk_ = 0;
#define GP_MARK() do { if (F.bid == 0) { const unsigned long long n_ = __builtin_amdgcn_s_memrealtime(); if (gpk_ == GPROBE) { const float us = 0.01f * (float)(n_ - gp0_); gpe_ = 100.f * exp2f(0.25f * rintf(4.f * log2f(fmaxf(us, 0.01f)))); } gp0_ = n_; } } while (0)
#else
#define GP_MARK() do {} while (0)
#endif
#define PHASE_BEGIN if (ph >= lo && ph < hi) { { int t_ = threadIdx.x; asm volatile("" : "+v"(t_)); F.tid = t_; F.lane = t_ & 63; F.wave = __builtin_amdgcn_readfirstlane(t_ >> 6); } \
    unsigned long long ka_ = (unsigned long long)__builtin_amdgcn_kernarg_segment_ptr(); asm volatile("" : "+s"(ka_)); CP& p = *(CP*)ka_;
#define PHASE_END(last) if (!(last) && ph + 1 < hi) { xcd_barrier(xbar); } } ++ph;
#define PHASE_END_NOWB(k) if (ph + 1 < hi) { if (lo == 0) flat_barrier(xbar, (unsigned)(k)); else xcd_barrier(xbar, false); } } ++ph;
#ifdef TPROBE0
    const unsigned long long tk0_ = __builtin_amdgcn_s_memrealtime(); float tke_ = 0.f;
#define TK(k) do { if (TPROBE0 == (k)) { const float us = 0.01f * (float)(__builtin_amdgcn_s_memrealtime() - tk0_); tke_ = 100.f * exp2f(0.25f * rintf(4.f * log2f(fmaxf(us, 0.01f)))); } } while (0)
#else
#define TK(k) do {} while (0)
#endif
    PHASE_BEGIN p0a_mod(F, p); __syncthreads(); p0a_rest(F, p); TK(2); PHASE_END(false) TSTAMP(0); TK(0);
    PHASE_BEGIN p0b(F, p);
#ifdef PROBE_P0X2
    xcd_barrier(xbar); p0a_mod(F, p); __syncthreads(); p0a_rest(F, p); xcd_barrier(xbar); p0b(F, p);
#endif
    TK(3); PHASE_END(false) TSTAMP(1); TK(1);
    for (int l = 0; l < NL; ++l) {
#ifdef GPROBE
        if (l == 1) { gpk_ = 0; GP_MARK(); }
#define GP_NEXT() do { if (l == 1) { ++gpk_; GP_MARK(); } } while (0)
#else
#define GP_NEXT() do {} while (0)
#endif
        PHASE_BEGIN {
            pg8::Gemm g{(const u16*)(p.ws + WS_AX), (const u16*)(p.ws + WS_WINT), M, NP, D};
            pg8::StaticOrder So; So.init(M, NP, F.G, F.bid);
            SP_BEG(5, 0); SP_BEG(7, 255);
            p1_rstd(F, p, So, l);
            EpiProj E{(u16*)(p.ws + WS_PROJ), (const LAS float*)(F.lds + LDS_SVT), (const LAS float*)(F.lds + LDS_RSTD)};
            pg8::gemm_phase<EpiProj, pg8::StaticOrder, true, true>(F.lds, g, So, E);
            SP_END(5, 0); SP_END(7, 255);
            if (l + 1 < NL && F.bid >= 64) { __syncthreads(); conv_weights_layer(F, p, l + 1, (F.bid - 64) * NWAVES + F.wave, (F.G - 64) * NWAVES, false, true); sw_layer(F, p, l + 1, F.bid - 64, F.G - 64); }
#ifdef PROBE_P1X2
            { int reps = 1; asm volatile("" : "+s"(reps));
#pragma unroll 1
              for (int rep = 0; rep < reps; ++rep) { __syncthreads(); pg8::gemm_phase<EpiProj, pg8::StaticOrder, true, true>(F.lds, g, So, E); } }
#endif
            TSTAMP(2);
        } PHASE_END(false) TSTAMP(3); GP_NEXT();
        PHASE_BEGIN SP_BEG(3, 0); p2a_rwkv_pre(F, p, l); SP_END(3, 0);
#ifdef ATTN_IN_P2A
        __syncthreads(); for (int u = F.bid; u < NB * NH * 8; u += F.G) attn_wg_unit(F, p, l, u >> 6, (u >> 3) & 7, u & 7);
#endif
#ifdef PROBE_P2AX2
        __syncthreads(); p2a_rwkv_pre(F, p, l);
#endif
        PHASE_END_NOWB(2 * l) GP_NEXT();
        PHASE_BEGIN SP_BEG(1, 0); SP_BEG(2, 64); p2_mixer(F, p, l); SP_END(1, 0); SP_END(2, 64);
#ifdef PROBE_P2X2
        __syncthreads(); p2_mixer(F, p, l);
#endif
        TSTAMP(4); PHASE_END(false) TSTAMP(5); GP_NEXT();
#ifdef PROBE_BARX
        for (int r_ = 0; r_ < PROBE_BARX; ++r_) xcd_barrier(xbar);
#endif
        PHASE_BEGIN SP_BEG(4, 0); p2c_post(F, p, l); SP_END(4, 0); PHASE_END_NOWB(2 * l + 1) GP_NEXT();
        PHASE_BEGIN {
            pg8::Gemm g{(const u16*)(p.ws + WS_YB), (const u16*)(p.ws + WS_WOUTT) + (size_t)(l & 1) * D * D, M, D, D};
            pg8::StaticOrder So; So.init(M, D, F.G, F.bid);
            const float* MOD = (const float*)(p.ws + WS_MOD);
            p3_tables(F, p, So, l);
            EpiOut E{l == 0 ? p.x : p.out, p.out, (const LAS float*)(F.lds + LDS_RSTD), (const LAS float*)(F.lds + LDS_RSTD) + 256, l + 1 < NL, (u16*)(p.ws + WS_AX), (float*)(p.ws + WS_PART)};
            SP_BEG(6, 0);
            pg8::gemm_phase<EpiOut, pg8::StaticOrder, true, true>(F.lds, g, So, E);
            SP_END(6, 0);
#ifdef PROBE_P3X2
            { __syncthreads();
              float* dump = (float*)(p.ws + WS_PROJ);
              EpiOut E2{p.x, dump, (const LAS float*)(F.lds + LDS_RSTD), (const LAS float*)(F.lds + LDS_RSTD) + 256, true, (u16*)(p.ws + WS_PROJ + 72 * MiB), dump + 18 * 1024 * 1024 + 9 * 1024 * 1024};
              pg8::gemm_phase<EpiOut, pg8::StaticOrder, true, true>(F.lds, g, So, E2); }
#endif
            TSTAMP(6);
        } PHASE_END(l == NL - 1) TSTAMP(7); GP_NEXT();
    }
#ifdef TPROBE0
    if (F.bid == 0 && F.tid == 0) p.out[0] += tke_;
#endif
#ifdef SPROBE
    if (F.tid == 0 && spe_ != 0.f) p.out[F.bid] += spe_;
#endif
#ifdef GPROBE
    if (F.bid == 0 && F.tid == 0) p.out[0] += gpe_;
#endif
#ifdef CPROBE
    xcd_barrier(xbar);
    if (F.bid == 0 && F.tid == 0) p.out[0] += *((const float*)(p.ws + WS_CTL) + 1024);
#endif
#ifdef APROBE
    xcd_barrier(xbar);
    if (F.bid == 0 && F.tid == 0) p.out[0] += *((const float*)(p.ws + WS_CTL) + 1024);
#endif
#ifdef TPROBE
    xcd_barrier(xbar);
    if (F.bid == 0 && F.tid == 0) p.out[0] += *((const float*)(p.ws + WS_CTL) + 1024);
#endif
#ifdef TIMING
    xcd_barrier(xbar);
    { const float ea = 10.f * 0.01f * (float)tspan[TIM_A], eb = 0.1f * 0.01f * (float)tspan[TIM_B];
      if (F.bid == 0) { const float ea_b = __builtin_bit_cast(float, __builtin_amdgcn_readfirstlane(__builtin_bit_cast(int, ea))), eb_b = __builtin_bit_cast(float, __builtin_amdgcn_readfirstlane(__builtin_bit_cast(int, eb)));
          for (int i = F.tid; i < (1 << 20); i += NTHR) p.out[i] += eb_b + (i == 0 ? ea_b : 0.f); } }
#endif
}

extern "C" void kernel_launch(void* const* d_in, const int* in_sizes, int n_in, void* d_out, int out_size, void* d_ws, size_t ws_size, hipStream_t stream) {
    static int grid = 0;
    if (grid == 0) {
        if (n_in != 20 || out_size != M * D || ws_size < WS_END) { fprintf(stderr, "kernel_launch: unexpected sizes n_in %d out %d ws %zu\n", n_in, out_size, ws_size); grid = -1; return; }
        int dev = 0, cus = 0, per_cu = 0;
        hipGetDevice(&dev); hipDeviceGetAttribute(&cus, hipDeviceAttributeMultiprocessorCount, dev);
        if (hipFuncSetAttribute((const void*)mk_fwd, hipFuncAttributeMaxDynamicSharedMemorySize, LDS_BYTES) != hipSuccess) { fprintf(stderr, "kernel_launch: hipFuncSetAttribute failed\n"); grid = -1; return; }
        if (hipOccupancyMaxActiveBlocksPerMultiprocessor(&per_cu, (const void*)mk_fwd, NTHR, LDS_BYTES) != hipSuccess || per_cu < 1) { fprintf(stderr, "kernel_launch: occupancy query says %d\n", per_cu); per_cu = 1; }
        (void)hipGetLastError();
        grid = cus;
    }
    if (grid < 0) return;
    Params p{};
    (void)hipMemsetAsync(d_ws, 0, 40960, stream);
    const float** pp = (const float**)&p;
    for (int i = 0; i < 20; ++i) pp[i] = (const float*)d_in[i];
    p.out = (float*)d_out; p.ws = (unsigned char*)d_ws;
#ifndef MK_N_PHASE_LAUNCHES
    p.ph_lo = 0; p.ph_hi = 2 + 5 * NL;
    void* args[] = {&p};
    hipError_t e = hipLaunchCooperativeKernel((const void*)mk_fwd, dim3(grid), dim3(NTHR), args, LDS_BYTES, stream);
    if (e != hipSuccess) fprintf(stderr, "cooperative launch failed: %s (grid %d)\n", hipGetErrorString(e), grid);
#else
    for (int ph = 0; ph < 2 + 5 * NL; ++ph) { p.ph_lo = ph; p.ph_hi = ph + 1; hipLaunchKernelGGL(mk_fwd, dim3(grid), dim3(NTHR), LDS_BYTES, stream, p); }
#endif
}
```

```cpp
#include <hip/hip_runtime.h>
#include <hip/hip_cooperative_groups.h>
#include <cstdio>
#include <cstdint>
namespace cg = cooperative_groups;
namespace pg8 {
#define PG8_LAS __attribute__((address_space(3)))
typedef unsigned short bf16_t;
typedef short bf16x8 __attribute__((ext_vector_type(8)));
typedef _Float16 f16x8 __attribute__((ext_vector_type(8)));
typedef float f32x4 __attribute__((ext_vector_type(4)));
typedef unsigned u32x4 __attribute__((ext_vector_type(4)));
constexpr int BM = 256, BK = 64, HALF = 128, HTB = HALF * BK * 2  , STAGE_BYTES = 8 * HTB, NXCD = 8, WGM = 8;

__host__ __device__ __forceinline__ int lds_byte(int r, int c) { const int st = (r >> 4) * 2 + (c >> 5), rr = r & 15, cc = c & 31, ob = rr * 64 + cc * 2; return st * 1024 + (ob ^ (((ob >> 9) & 1) << 5)); }
__host__ __device__ __forceinline__ void stage_rc(int b, int& R, int& C) { const int st = b / 1024, sb = b % 1024, swz = sb ^ (((sb >> 9) & 1) << 5); R = (st >> 1) * 16 + swz / 64; C = (st & 1) * 32 + (swz % 64) / 2; }
__host__ __device__ __forceinline__ int perm32(int rho) { const int n = rho >> 4, i = rho & 15; return 8 * (i >> 2) + 4 * n + (i & 3); }

struct Unit { int pm, pn, ord; };
struct Gemm { const bf16_t* A; const bf16_t* Bt; int M, N, K; };

struct StaticOrder {
    int nM, nN, nwg, G, c;
    __host__ __device__ void init(int M, int N, int G_, int c_) { nM = M / BM; nN = N / BM; nwg = nM * nN; G = G_; c = c_; }
    __host__ __device__ bool next(int i, Unit& u) const {
        const long L = (long)i * G + c; if (L >= nwg) return false;
        int wgid = (int)L; { const int q = nwg / NXCD, r = nwg % NXCD, xcd = wgid % NXCD, off = wgid / NXCD; wgid = (xcd < r ? xcd * (q + 1) : r * (q + 1) + (xcd - r) * q) + off; }
        const int nig = WGM * nN, gid = wgid / nig, fm = gid * WGM, gsz = (nM - fm) < WGM ? (nM - fm) : WGM;
        u.pm = fm + ((wgid % nig) % gsz); u.pn = (wgid % nig) / gsz; u.ord = i; return true;
    }
    __device__ __forceinline__ void a_ready(const Unit&) const {}
    __device__ __forceinline__ void done(const Unit&) const {}
};


template <class Epi, class Sched, bool ALIGN_EPI = false, bool SP2 = false>
__device__ __forceinline__ void gemm_phase(PG8_LAS unsigned char* lds, const Gemm g, const Sched& S, const Epi& E) {
    int tid_ = threadIdx.x; asm volatile("" : "+v"(tid_));
    const int tid = tid_, wid = __builtin_amdgcn_readfirstlane(tid >> 6), lane = tid & 63, wr = wid >> 2, wc = wid & 3, fr = lane & 15, fq = lane >> 4;
    const int K = g.K, nt = K / BK;
    unsigned voffA[2], voffB[2];
#pragma unroll
    for (int i = 0; i < 2; ++i) { int R, C; stage_rc(tid * 16 + i * 8192, R, C); const int Rb = Epi::PERM ? ((R & ~31) + perm32(R & 31)) : R;
        voffA[i] = (unsigned)(R * K + C) * 2u; voffB[i] = (unsigned)(Rb * K + C) * 2u; }
    const size_t kstep = (size_t)(BK * 2);
    const size_t hstep = (size_t)HALF * K * 2;
    const size_t tstep = 2 * hstep;
    const unsigned ldsw = (unsigned)wid * 1024u;
    const int aoff = lds_byte(wr * 64 + fr, fq * 8), boff = lds_byte(wc * 32 + fr, fq * 8);
#define PG8_SA(b, h) (((b) * 2 + (h)) * HTB)
#define PG8_SB(b, h) ((4 + (b) * 2 + (h)) * HTB)
#define PG8_STAGE(bufoff, gbase, voff) do { _Pragma("unroll") for (int _i = 0; _i < 2; ++_i) \
        __builtin_amdgcn_global_load_lds((const unsigned*)((const char*)(gbase) + (voff)[_i]), (PG8_LAS unsigned*)(lds + (bufoff) + ldsw + _i * 8192), 16, 0, 0); } while (0)
#define PG8_LDA(dst, b, h) do { _Pragma("unroll") for (int m = 0; m < 4; ++m) _Pragma("unroll") for (int k = 0; k < 2; ++k) dst[m][k] = *(const PG8_LAS f16x8*)(lds + PG8_SA(b, h) + aoff + m * 2048 + k * 1024); } while (0)
#define PG8_LDB(dst, b, h) do { _Pragma("unroll") for (int n = 0; n < 2; ++n) _Pragma("unroll") for (int k = 0; k < 2; ++k) dst[n][k] = *(const PG8_LAS f16x8*)(lds + PG8_SB(b, h) + boff + n * 2048 + k * 1024); } while (0)
#define PG8_MMA(ai, bj, At, Bt) do { __builtin_amdgcn_s_setprio(1); _Pragma("unroll") for (int m = 0; m < 4; ++m) _Pragma("unroll") for (int n = 0; n < 2; ++n) _Pragma("unroll") for (int k = 0; k < 2; ++k) \
        acc[ai][bj][m][n] = __builtin_amdgcn_mfma_f32_16x16x32_f16(Bt[n][k], At[m][k], acc[ai][bj][m][n], 0, 0, 0); __builtin_amdgcn_s_setprio(0); } while (0)
#define PG8_WAIT_V(n) asm volatile("s_waitcnt vmcnt(" #n ")" ::: "memory")
#define PG8_WAIT_L(n) asm volatile("s_waitcnt lgkmcnt(" #n ")" ::: "memory")
#define PG8_BAR __builtin_amdgcn_s_barrier()
#define PG8_SCHED __builtin_amdgcn_sched_barrier(0)
    Unit cur, nxt; int ui = 0;
    if (!S.next(0, cur)) return;
    f32x4 acc[2][2][4][2];
#pragma unroll
    for (int a = 0; a < 2; ++a)
#pragma unroll
        for (int b = 0; b < 2; ++b)
#pragma unroll
            for (int m = 0; m < 4; ++m)
#pragma unroll
                for (int n = 0; n < 2; ++n) acc[a][b][m][n] = (f32x4){0.f, 0.f, 0.f, 0.f};
    f16x8 At[4][2], B0[2][2], B1[2][2];
    const char* cA = (const char*)g.A + (size_t)cur.pm * tstep; const char* cB = (const char*)g.Bt + (size_t)cur.pn * tstep;
    S.a_ready(cur);
    if constexpr (SP2) {
        PG8_STAGE(PG8_SB(0, 0), cB, voffB); PG8_STAGE(PG8_SB(0, 1), cB + hstep, voffB); PG8_STAGE(PG8_SA(0, 0), cA, voffA); PG8_STAGE(PG8_SA(0, 1), cA + hstep, voffA);
        if (wr == 1) PG8_BAR;
        PG8_WAIT_V(2); PG8_BAR;
        PG8_STAGE(PG8_SB(1, 0), cB + kstep, voffB); PG8_STAGE(PG8_SA(1, 0), cA + kstep, voffA); PG8_STAGE(PG8_SB(1, 1), cB + hstep + kstep, voffB);
        PG8_WAIT_V(6); PG8_BAR;
    } else {
        PG8_STAGE(PG8_SB(0, 0), cB, voffB); PG8_STAGE(PG8_SA(0, 0), cA, voffA); PG8_STAGE(PG8_SB(0, 1), cB + hstep, voffB); PG8_STAGE(PG8_SA(0, 1), cA + hstep, voffA);
        if (wr == 1) PG8_BAR;
        PG8_WAIT_V(4); PG8_BAR;
        PG8_STAGE(PG8_SB(1, 0), cB + kstep, voffB); PG8_STAGE(PG8_SA(1, 0), cA + kstep, voffA); PG8_STAGE(PG8_SB(1, 1), cB + hstep + kstep, voffB);
        PG8_WAIT_V(6); PG8_BAR;
    }
    for (;;) {
        const bool has_next = S.next(ui + 1, nxt);
        const char* nA = has_next ? (const char*)g.A + (size_t)nxt.pm * tstep : cA; const char* nB = has_next ? (const char*)g.Bt + (size_t)nxt.pn * tstep : cB;
        for (int t = 0; t < nt; t += 2) {
            const bool last = (t == nt - 2);
            const char* a1 = cA + (size_t)(t + 1) * kstep;
            const char* a2 = last ? nA : cA + (size_t)(t + 2) * kstep; const char* b2 = last ? nB : cB + (size_t)(t + 2) * kstep;
            const char* a3 = a2 + kstep; const char* b3 = b2 + kstep;
            if (last && has_next) S.a_ready(nxt);
            if constexpr (SP2) {
            PG8_LDB(B0, 0, 0); PG8_LDB(B1, 0, 1); PG8_SCHED; PG8_LDA(At, 0, 0); PG8_STAGE(PG8_SA(1, 1), a1 + hstep, voffA);
            PG8_WAIT_V(8); PG8_WAIT_L(0); PG8_BAR; PG8_MMA(0, 0, At, B0); PG8_MMA(0, 1, At, B1); PG8_BAR; PG8_SCHED;
            PG8_LDA(At, 0, 1); PG8_STAGE(PG8_SB(0, 0), b2, voffB); PG8_STAGE(PG8_SB(0, 1), b2 + hstep, voffB); PG8_STAGE(PG8_SA(0, 0), a2, voffA);
            PG8_WAIT_V(8); PG8_WAIT_L(0); PG8_BAR; PG8_MMA(1, 0, At, B0); PG8_MMA(1, 1, At, B1); PG8_BAR; PG8_SCHED;
            PG8_LDB(B0, 1, 0); PG8_LDB(B1, 1, 1); PG8_SCHED; PG8_LDA(At, 1, 0); PG8_STAGE(PG8_SA(0, 1), a2 + hstep, voffA);
            PG8_WAIT_V(8); PG8_WAIT_L(0); PG8_BAR; PG8_MMA(0, 0, At, B0); PG8_MMA(0, 1, At, B1); PG8_BAR; PG8_SCHED;
            PG8_LDA(At, 1, 1); PG8_STAGE(PG8_SB(1, 0), b3, voffB); PG8_STAGE(PG8_SB(1, 1), b3 + hstep, voffB); PG8_STAGE(PG8_SA(1, 0), a3, voffA);
            PG8_WAIT_V(8); PG8_WAIT_L(0); PG8_BAR; PG8_MMA(1, 0, At, B0); PG8_MMA(1, 1, At, B1); PG8_BAR; PG8_SCHED;
            } else {
            PG8_LDB(B0, 0, 0); PG8_SCHED; PG8_LDA(At, 0, 0); PG8_STAGE(PG8_SA(1, 1), a1 + hstep, voffA);
            PG8_WAIT_L(8); PG8_BAR; PG8_WAIT_L(0); PG8_MMA(0, 0, At, B0); PG8_BAR; PG8_SCHED;
            PG8_LDB(B1, 0, 1); PG8_STAGE(PG8_SB(0, 0), b2, voffB);
            PG8_BAR; PG8_WAIT_L(0); PG8_MMA(0, 1, At, B1); PG8_BAR;
            PG8_LDA(At, 0, 1); PG8_STAGE(PG8_SA(0, 0), a2, voffA);
            PG8_BAR; PG8_WAIT_L(0); PG8_MMA(1, 0, At, B0); PG8_BAR; PG8_SCHED;
            PG8_STAGE(PG8_SB(0, 1), b2 + hstep, voffB);
            PG8_WAIT_V(6); PG8_BAR; PG8_MMA(1, 1, At, B1); PG8_BAR;
            PG8_LDB(B0, 1, 0); PG8_SCHED; PG8_LDA(At, 1, 0); PG8_STAGE(PG8_SA(0, 1), a2 + hstep, voffA);
            PG8_WAIT_L(8); PG8_BAR; PG8_WAIT_L(0); PG8_MMA(0, 0, At, B0); PG8_BAR; PG8_SCHED;
            PG8_LDB(B1, 1, 1); PG8_STAGE(PG8_SB(1, 0), b3, voffB);
            PG8_BAR; PG8_WAIT_L(0); PG8_MMA(0, 1, At, B1); PG8_BAR;
            PG8_LDA(At, 1, 1); PG8_STAGE(PG8_SA(1, 0), a3, voffA);
            PG8_BAR; PG8_WAIT_L(0); PG8_MMA(1, 0, At, B0); PG8_BAR; PG8_SCHED;
            PG8_STAGE(PG8_SB(1, 1), b3 + hstep, voffB);
            PG8_WAIT_V(6); PG8_BAR; PG8_MMA(1, 1, At, B1); PG8_BAR;
            }
        }
        if constexpr (ALIGN_EPI) { if (wr == 0) PG8_BAR; }
        if constexpr (!Epi::AFTER_DRAIN) { E(acc, cur, wr, wc, fr, fq); S.done(cur); }
        if (!has_next) break;
#pragma unroll
        for (int a = 0; a < 2; ++a)
#pragma unroll
            for (int b = 0; b < 2; ++b)
#pragma unroll
                for (int m = 0; m < 4; ++m)
#pragma unroll
                    for (int n = 0; n < 2; ++n) acc[a][b][m][n] = (f32x4){0.f, 0.f, 0.f, 0.f};
        cur = nxt; cA = nA; cB = nB; ++ui;
        if constexpr (ALIGN_EPI) { if (wr == 1) PG8_BAR; }
    }
    PG8_WAIT_V(0);
    if constexpr (!ALIGN_EPI) { if (wr == 0) PG8_BAR; }
    PG8_BAR;
    if constexpr (Epi::AFTER_DRAIN) { E.fused(acc, cur, wr, wc, fr, fq, lds, wid, lane); S.done(cur); }
#undef PG8_SA
#undef PG8_SB
#undef PG8_STAGE
#undef PG8_LDA
#undef PG8_LDB
#undef PG8_MMA
#undef PG8_WAIT_V
#undef PG8_WAIT_L
#undef PG8_BAR
#undef PG8_SCHED
}
}


constexpr int D = 1024, NB = 8, S = 2048, NL = 4, M = NB * S;
constexpr int DIN = 4224, DSH = 2176, DR = 512, NH = 8, HD = 64, NREL = 192;
constexpr int NP = 4352;
constexpr int PC_R = 0, PC_K = 512, PC_V = 1024, PC_G = 1536, PC_WD = 2048, PC_AD = 2112, PC_Q = 2304, PC_KA = 2816, PC_VA = 3328, PC_GA = 3840;
constexpr int NWAVES = 8, NTHR = 512;
constexpr size_t SW_HALF = (size_t)8 * NP;
constexpr size_t MiB = 1u << 20;
constexpr size_t WS_W2T = 1 * MiB + 512 * 1024, WS_A2T = 1 * MiB + 768 * 1024, WS_BDG = 256 * 1024  ;
constexpr size_t WS_CTL = 0, WS_MOD = 1 * MiB, WS_SW = 2 * MiB, WS_PART = 3 * MiB, WS_WINT = 4 * MiB  , WS_WOUTT = 12 * MiB + 512 * 1024  ,
                 WS_AX = 16 * MiB + 512 * 1024, WS_YB = 48 * MiB + 512 * 1024, WS_PROJ = 80 * MiB + 512 * 1024, WS_IMGB = 216 * MiB + 512 * 1024, WS_END = 264 * MiB;
constexpr int IMG_BYTES = 10048, IMG_NA = 26 * 128;
constexpr int IM_WT = 0, IM_RH = 2048, IM_BB = 4096, IM_KB = 6144, IM_MUKT = 8192, IM_ARBT = 8704, IM_ARKT = 9216, IM_GAM = 9728, IM_BD = 9984;
static_assert((size_t)IMG_NA * IMG_BYTES <= 32 * MiB && (size_t)(8192 - IMG_NA) * IMG_BYTES <= WS_END - WS_IMGB, "image storage");
__device__ __forceinline__ unsigned char* img_ptr(unsigned char* ws, int unit) { return unit < IMG_NA ? ws + WS_AX + (size_t)unit * IMG_BYTES : ws + WS_IMGB + (size_t)(unit - IMG_NA) * IMG_BYTES; }
constexpr int LDS_BYTES = 147456;
constexpr int LDS_RSTD = 131072, P1_MAXU = 6, LDS_SVT = LDS_RSTD + P1_MAXU * 1024;
constexpr int LDS_MISC = 147456 - 256;
constexpr int CW_Q = 9216;
constexpr int CW_BAR = 4096;

#define GAS __attribute__((address_space(1)))
#define LAS __attribute__((address_space(3)))
typedef unsigned short u16;
typedef float f32x4 __attribute__((ext_vector_type(4)));
typedef float f32x2 __attribute__((ext_vector_type(2)));
typedef unsigned u32x4 __attribute__((ext_vector_type(4)));
typedef unsigned u32x2 __attribute__((ext_vector_type(2)));
typedef _Float16 f16x2 __attribute__((ext_vector_type(2)));
typedef _Float16 f16x4 __attribute__((ext_vector_type(4)));
typedef _Float16 f16x8 __attribute__((ext_vector_type(8)));

__device__ __forceinline__ unsigned pk_f16(float lo, float hi) { f32x2 v = {lo, hi}; f16x2 h = __builtin_convertvector(v, f16x2); return __builtin_bit_cast(unsigned, h); }
__device__ __forceinline__ float h2f(u16 h) { return (float)__builtin_bit_cast(_Float16, h); }
__device__ __forceinline__ u16 f2h(float f) { return __builtin_bit_cast(u16, (_Float16)f); }
__device__ __forceinline__ float wave_sum(float v) {
#pragma unroll
    for (int o = 1; o < 64; o <<= 1) v += __shfl_xor(v, o);
    return v;
}
__device__ __forceinline__ float red_x32(float x) {
    auto r32 = __builtin_amdgcn_permlane32_swap(__float_as_uint(x), __float_as_uint(x), false, false);
    return __uint_as_float(r32[0]) + __uint_as_float(r32[1]); }
__device__ __forceinline__ float red_rows(float x) {
    auto r16 = __builtin_amdgcn_permlane16_swap(__float_as_uint(x), __float_as_uint(x), false, false);
    return red_x32(__uint_as_float(r16[0]) + __uint_as_float(r16[1])); }
__device__ __forceinline__ float sigmoidf_(float x) { return 1.f / (1.f + __expf(-x)); }
__device__ __forceinline__ void st16_wt(void* p, u32x4 v) { asm volatile("global_store_dwordx4 %0, %1, off sc1\n\ts_nop 1" :: "v"(p), "v"(v) : "memory"); }

struct Params {
    const float *x, *c, *norm_g, *w_ada, *b_ada, *w_in, *mu, *w0, *w2, *a0, *a2, *k_k, *k_a, *r_k, *lnx_g, *lnx_b, *qg, *kg, *rel_bias, *w_out;
    float* out; unsigned char* ws; int ph_lo, ph_hi;
};
typedef const __attribute__((address_space(4))) Params CP;


typedef GAS unsigned gu32;
#define XB_TMO      128
#define XB_XCNT(j)  (256  + 64 * (j))
#define XB_XSUB(j)  (1280 + 64 * (j))
#define XB_XGEN(j)  (2304 + 64 * (j))
#define XB_TOP      3328
#define XB_TOPGEN   3392
#define XCD_BAR_WORDS 3456
#define FB_CNT      3520
#define FB_REL(j)   (3584 + 64 * (j))
#define XB_SPIN_CAP (1u << 18)

__device__ __forceinline__ unsigned xb_ld(unsigned* p)              { return __hip_atomic_load(p, __ATOMIC_RELAXED, __HIP_MEMORY_SCOPE_AGENT); }
__device__ __forceinline__ unsigned xb_add(unsigned* p, unsigned v) { return __hip_atomic_fetch_add(p, v, __ATOMIC_RELAXED, __HIP_MEMORY_SCOPE_AGENT); }
__device__ __forceinline__ unsigned xb_xcc_id() { return (unsigned)__builtin_amdgcn_s_getreg((3 << 11) | 20) & 0xFu; }
#define XB_SPIN(cond, bar) do { unsigned _sp = 0; while (cond) { __builtin_amdgcn_s_sleep(1); \
    if ((++_sp & 255u) == 0u) { if (xb_ld(&(bar)[XB_TMO])) break; if (_sp > XB_SPIN_CAP) { atomicAdd(&(bar)[XB_TMO], 1u); break; } } } } while (0)

struct XcdBarrier {
    unsigned* bar; unsigned x;
    volatile LAS unsigned* st;
};

__device__ __forceinline__ XcdBarrier xcd_barrier_post(unsigned* bar, volatile LAS unsigned* st) {
    XcdBarrier b; b.bar = bar; b.x = xb_xcc_id(); b.st = st;
    if (threadIdx.x == 0) (void)xb_add(&bar[XB_XCNT(b.x)], 1u);
    return b;
}
__device__ __forceinline__ void xcd_barrier_complete(unsigned* bar, unsigned x, unsigned& nloc, unsigned& nx) {
    const unsigned G = gridDim.x * gridDim.y * gridDim.z;
    unsigned sum, cnt, mine, sp = 0u;
    for (;;) {
        sum = 0u; cnt = 0u; mine = 0u;
#pragma unroll
        for (unsigned j = 0; j < 16; ++j) { const unsigned c = xb_ld(&bar[XB_XCNT(j)]); sum += c; cnt += (c > 0u) ? 1u : 0u; mine = (j == x) ? c : mine; }
        if (sum == G) break;
        __builtin_amdgcn_s_sleep(1);
        if ((++sp & 255u) == 0u) { if (xb_ld(&bar[XB_TMO])) break; if (sp > XB_SPIN_CAP) { atomicAdd(&bar[XB_TMO], 1u); break; } }
    }
    nloc = mine > 0u ? mine : 1u; nx = cnt > 0u ? cnt : 1u;
}

__device__ __forceinline__ void xcd_barrier(const XcdBarrier& b, bool wb = true) {
    asm volatile("s_waitcnt vmcnt(0)" ::: "memory");
    __syncthreads();
    if (threadIdx.x == 0) {
        unsigned* bar = b.bar;
        __builtin_amdgcn_s_waitcnt(0);
        unsigned nloc = b.st[0], nx = b.st[1];
        if (nloc == 0u) { xcd_barrier_complete(bar, b.x, nloc, nx); b.st[0] = nloc; b.st[1] = nx; }
        asm volatile("buffer_inv sc1" ::: "memory");
        const unsigned old = xb_add(&bar[XB_XSUB(b.x)], 1u);
        const unsigned gen = old / nloc;
        if (old + 1u == (gen + 1u) * nloc) {
            if (wb) __builtin_amdgcn_fence(__ATOMIC_RELEASE, "agent");
            asm volatile("s_waitcnt vmcnt(0)" ::: "memory");
            (void)xb_add(&bar[XB_TOP], 1u);
            XB_SPIN(xb_ld(&bar[XB_TOP]) < (gen + 1u) * nx, bar);
            xb_add(&bar[XB_XGEN(b.x)], 1u);
            asm volatile("s_waitcnt vmcnt(0)" ::: "memory");
        } else {
            XB_SPIN(xb_ld(&bar[XB_XGEN(b.x)]) == gen, bar);
            asm volatile("s_waitcnt vmcnt(0)" ::: "memory");
        }
    }
    __syncthreads();
}

__device__ __forceinline__ void flat_barrier(const XcdBarrier& b, unsigned k) {
    asm volatile("s_waitcnt vmcnt(0)" ::: "memory");
    __syncthreads();
    if (threadIdx.x == 0) {
        unsigned* bar = b.bar; const unsigned G = gridDim.x * gridDim.y * gridDim.z;
        asm volatile("buffer_inv sc1" ::: "memory");
        const unsigned old = xb_add(&bar[FB_CNT], 1u);
        if (old + 1u == (k + 1u) * G) {
#pragma unroll
            for (int j = 0; j < 16; ++j) __hip_atomic_store(&bar[FB_REL(j)], k + 1u, __ATOMIC_RELAXED, __HIP_MEMORY_SCOPE_AGENT);
        } else XB_SPIN(xb_ld(&bar[FB_REL(b.x & 15u)]) < k + 1u, bar);
        asm volatile("s_waitcnt vmcnt(0)" ::: "memory");
    }
    __syncthreads();
}

struct EpiProj {
    static constexpr bool PERM = true, AFTER_DRAIN = false;
    u16* O; const LAS float* svt; const LAS float* rstd;
    __device__ __forceinline__ void operator()(const pg8::f32x4 (&acc)[2][2][4][2], const pg8::Unit& u, int wr, int wc, int fr, int fq) const {
        const int col0 = u.pn * 256 + wc * 32 + 8 * fq;
        f32x4 sv[2][2];
#pragma unroll
        for (int bj = 0; bj < 2; ++bj)
#pragma unroll
            for (int n = 0; n < 2; ++n) sv[bj][n] = *(const LAS f32x4*)(svt + u.ord * 256 + wc * 32 + 8 * fq + bj * 128 + 4 * n);
#pragma unroll
        for (int ai = 0; ai < 2; ++ai)
#pragma unroll
            for (int m = 0; m < 4; ++m) {
                const int rl = ai * 128 + wr * 64 + m * 16 + fr; const float rs = rstd[u.ord * 256 + rl];
                u16* rowp = O + (size_t)(u.pm * 256 + rl) * NP + col0;
#pragma unroll
                for (int bj = 0; bj < 2; ++bj) {
                    const f32x4 v0 = acc[ai][bj][m][0] * rs + sv[bj][0], v1 = acc[ai][bj][m][1] * rs + sv[bj][1];
                    u32x4 w; w.x = pk_f16(v0[0], v0[1]); w.y = pk_f16(v0[2], v0[3]); w.z = pk_f16(v1[0], v1[1]); w.w = pk_f16(v1[2], v1[3]);
                    *(u32x4*)(rowp + bj * 128) = w; }
            }
    }
};
struct EpiOut {
    static constexpr bool PERM = true, AFTER_DRAIN = false;
    const float* xold; float* xout; const LAS float* gt;   const LAS float* Gt;   bool ng;   u16* AX; float* part;
    __device__ __forceinline__ void operator()(const pg8::f32x4 (&acc)[2][2][4][2], const pg8::Unit& u, int wr, int wc, int fr, int fq) const {
        const int col0 = u.pn * 256 + wc * 32 + 8 * fq;
        f32x4 gv[2][2], Gn[2][2];
#pragma unroll
        for (int bj = 0; bj < 2; ++bj)
#pragma unroll
            for (int n = 0; n < 2; ++n) { const int cl = wc * 32 + 8 * fq + bj * 128 + 4 * n;
                gv[bj][n] = *(const LAS f32x4*)(gt + cl); Gn[bj][n] = *(const LAS f32x4*)(Gt + cl); }
        constexpr int PD = 2; f32x4 xq[8][2][2];
        auto xload = [&](int g) { const int r = u.pm * 256 + (g >> 2) * 128 + wr * 64 + (g & 3) * 16 + fr;
#pragma unroll
            for (int bj = 0; bj < 2; ++bj) { const size_t off = (size_t)r * D + col0 + bj * 128;
                xq[g][bj][0] = __builtin_nontemporal_load((const f32x4*)(xold + off)); xq[g][bj][1] = __builtin_nontemporal_load((const f32x4*)(xold + off + 4)); } };
#pragma unroll
        for (int g = 0; g < PD; ++g) xload(g);
#pragma unroll
        for (int ai = 0; ai < 2; ++ai)
#pragma unroll
            for (int m = 0; m < 4; ++m) {
                const int r = u.pm * 256 + ai * 128 + wr * 64 + m * 16 + fr; float ss = 0.f;
                if (ai * 4 + m + PD < 8) xload(ai * 4 + m + PD);
#pragma unroll
                for (int bj = 0; bj < 2; ++bj) {
                    const size_t off = (size_t)r * D + col0 + bj * 128;
                    const f32x4 x0 = xq[ai * 4 + m][bj][0], x1 = xq[ai * 4 + m][bj][1];
                    const f32x4 n0 = x0 + gv[bj][0] * acc[ai][bj][m][0], n1 = x1 + gv[bj][1] * acc[ai][bj][m][1];
                    *(f32x4*)(xout + off) = n0; *(f32x4*)(xout + off + 4) = n1;
                    ss += (n0[0] * n0[0] + n0[1] * n0[1]) + (n0[2] * n0[2] + n0[3] * n0[3]) + (n1[0] * n1[0] + n1[1] * n1[1]) + (n1[2] * n1[2] + n1[3] * n1[3]);
                    if (ng) { const f32x4 a0 = n0 * Gn[bj][0], a1 = n1 * Gn[bj][1];
                        u32x4 w; w.x = pk_f16(a0[0], a0[1]); w.y = pk_f16(a0[2], a0[3]); w.z = pk_f16(a1[0], a1[1]); w.w = pk_f16(a1[2], a1[3]);
                        *(u32x4*)(AX + off) = w; }
                }
                ss += __shfl_xor(ss, 16); ss += __shfl_xor(ss, 32);
                if (ng && fq == 0) part[(size_t)r * 16 + u.pn * 4 + wc] = ss;
            }
    }
};

struct Frame {
    LAS unsigned char* lds; int tid, lane, wave, G, bid;
};

template <int MODE>
__device__ __forceinline__ void gemv8_item(Frame& F, const LAS float* vec, const float* W, int ldw, int n0, const float* bias, float* outp, int ldo) {
    LAS float* red = (LAS float*)(F.lds + 65536);
    const int n = n0 + F.lane; int src = n; bool valid = true;
    if (MODE == 1) { if (n < DSH) src = n; else if (n < PC_Q) { valid = false; src = 0; } else src = n - 128; }
    float acc[8];
#pragma unroll
    for (int b = 0; b < 8; ++b) acc[b] = 0.f;
    if (MODE == 0) {
#define GV_BLK(w0, w1, w2, w3, w4, w5, w6, w7) asm volatile( \
            "global_load_dword %0, %8, %9 nt\n\tv_add_u32 %8, %10, %8\n\tglobal_load_dword %1, %8, %9 nt\n\tv_add_u32 %8, %10, %8\n\t" \
            "global_load_dword %2, %8, %9 nt\n\tv_add_u32 %8, %10, %8\n\tglobal_load_dword %3, %8, %9 nt\n\tv_add_u32 %8, %10, %8\n\t" \
            "global_load_dword %4, %8, %9 nt\n\tv_add_u32 %8, %10, %8\n\tglobal_load_dword %5, %8, %9 nt\n\tv_add_u32 %8, %10, %8\n\t" \
            "global_load_dword %6, %8, %9 nt\n\tv_add_u32 %8, %10, %8\n\tglobal_load_dword %7, %8, %9 nt\n\tv_add_u32 %8, %10, %8" \
            : "=&v"(w0), "=&v"(w1), "=&v"(w2), "=&v"(w3), "=&v"(w4), "=&v"(w5), "=&v"(w6), "=&v"(w7), "+v"(voff) : "s"(wbase), "s"(rstride))
#define GV_WAIT(N, a) asm volatile("s_waitcnt vmcnt(" #N ")" : "+v"(a[0]), "+v"(a[1]), "+v"(a[2]), "+v"(a[3]), "+v"(a[4]), "+v"(a[5]), "+v"(a[6]), "+v"(a[7]), "+v"(a[8]), "+v"(a[9]), "+v"(a[10]), "+v"(a[11]), \
            "+v"(a[12]), "+v"(a[13]), "+v"(a[14]), "+v"(a[15]))
        const float* wbase = W + (size_t)(F.wave * 128) * ldw; const int rstride = ldw * 4; int voff = src * 4;
#pragma unroll 1
        for (int k0 = 0; k0 < 128; k0 += 32) {
            float wa[16], wb[16];
            GV_BLK(wa[0], wa[1], wa[2], wa[3], wa[4], wa[5], wa[6], wa[7]); GV_BLK(wa[8], wa[9], wa[10], wa[11], wa[12], wa[13], wa[14], wa[15]);
            GV_BLK(wb[0], wb[1], wb[2], wb[3], wb[4], wb[5], wb[6], wb[7]); GV_BLK(wb[8], wb[9], wb[10], wb[11], wb[12], wb[13], wb[14], wb[15]);
            GV_WAIT(16, wa);
#pragma unroll
            for (int k4 = 0; k4 < 16; k4 += 4)
#pragma unroll
                for (int b = 0; b < 8; ++b) { const f32x4 vv = *(const LAS f32x4*)(vec + b * 1024 + F.wave * 128 + k0 + k4);
                    acc[b] += (vv[0] * wa[k4] + vv[1] * wa[k4 + 1]) + (vv[2] * wa[k4 + 2] + vv[3] * wa[k4 + 3]); }
            GV_WAIT(0, wb);
#pragma unroll
            for (int k4 = 0; k4 < 16; k4 += 4)
#pragma unroll
                for (int b = 0; b < 8; ++b) { const f32x4 vv = *(const LAS f32x4*)(vec + b * 1024 + F.wave * 128 + k0 + 16 + k4);
                    acc[b] += (vv[0] * wb[k4] + vv[1] * wb[k4 + 1]) + (vv[2] * wb[k4 + 2] + vv[3] * wb[k4 + 3]); }
        }
#undef GV_BLK
#undef GV_WAIT
    } else {
    const float* wp = W + (size_t)(F.wave * 128) * ldw + src;
#pragma unroll 1
    for (int k0 = 0; k0 < 128; k0 += 16) {
        float wv[16];
#pragma unroll
        for (int k = 0; k < 16; ++k) wv[k] = valid ? __builtin_nontemporal_load(wp + (size_t)(k0 + k) * ldw) : 0.f;
#pragma unroll
        for (int k4 = 0; k4 < 16; k4 += 4)
#pragma unroll
            for (int b = 0; b < 8; ++b) { const f32x4 vv = *(const LAS f32x4*)(vec + b * 1024 + F.wave * 128 + k0 + k4);
                acc[b] += (vv[0] * wv[k4] + vv[1] * wv[k4 + 1]) + (vv[2] * wv[k4 + 2] + vv[3] * wv[k4 + 3]); }
    }
    }
#pragma unroll
    for (int b = 0; b < 8; ++b) red[(F.wave * 8 + b) * 64 + F.lane] = acc[b];
    __syncthreads();
    { const int b = F.tid >> 6, ln = F.tid & 63; float s = 0.f;
#pragma unroll
      for (int w = 0; w < 8; ++w) s += red[(w * 8 + b) * 64 + ln];
      const int nn = n0 + ln;
      outp[(size_t)b * ldo + nn] = s + (bias ? bias[nn] : 0.f); }
    __syncthreads();
}

__device__ __forceinline__ void gemv8h_item(Frame& F, const LAS float* vec, const float* W, int ldw, int n0, int half, float* outp, int ldo) {
    LAS float* red = (LAS float*)(F.lds + 65536);
    const int n = n0 + F.lane; int src = n; bool valid = true;
    if (n < DSH) src = n; else if (n < PC_Q) { valid = false; src = 0; } else src = n - 128;
    float acc[8];
#pragma unroll
    for (int b = 0; b < 8; ++b) acc[b] = 0.f;
    const int kb = half * 512 + F.wave * 64;
    const float* wp = W + (size_t)kb * ldw + src;
#pragma unroll 1
    for (int k0 = 0; k0 < 64; k0 += 16) {
        float wv[16];
#pragma unroll
        for (int k = 0; k < 16; ++k) wv[k] = valid ? __builtin_nontemporal_load(wp + (size_t)(k0 + k) * ldw) : 0.f;
#pragma unroll
        for (int k4 = 0; k4 < 16; k4 += 4)
#pragma unroll
            for (int b = 0; b < 8; ++b) { const f32x4 vv = *(const LAS f32x4*)(vec + b * 1024 + kb + k0 + k4);
                acc[b] += (vv[0] * wv[k4] + vv[1] * wv[k4 + 1]) + (vv[2] * wv[k4 + 2] + vv[3] * wv[k4 + 3]); }
    }
#pragma unroll
    for (int b = 0; b < 8; ++b) red[(F.wave * 8 + b) * 64 + F.lane] = acc[b];
    __syncthreads();
    { const int b = F.tid >> 6, ln = F.tid & 63; float sacc = 0.f;
#pragma unroll
      for (int w = 0; w < 8; ++w) sacc += red[(w * 8 + b) * 64 + ln];
      outp[(size_t)b * ldo + n0 + ln] = sacc; }
    __syncthreads();
}
__device__ __forceinline__ void p0a_mod(Frame& F, CP& p) {
    LAS float* vec = (LAS float*)F.lds;
    for (int i = F.tid; i < 8 * 1024; i += NTHR) { const float v = p.c[i]; vec[i] = v * sigmoidf_(v); }
    __syncthreads();
    float* MOD = (float*)(p.ws + WS_MOD);
    for (int it = F.bid; it < NL * 48; it += F.G) { const int l = it / 48, nb = it % 48;
        gemv8_item<0>(F, vec, p.w_ada + (size_t)l * D * 3072, 3072, nb * 64, p.b_ada + l * 3072, MOD + (size_t)l * 8 * 3072, 3072); }
}

__device__ __forceinline__ void p0_transpose_item(const float* W, int K, int N, int ncol0_src, bool valid, u16* WT, int dst_row0, int k0, LAS float* scr, int lane) {
    { float tv[32];
#pragma unroll
      for (int i = 0; i < 32; ++i) { const int kk = 2 * i + (lane >> 5); tv[i] = valid ? __builtin_nontemporal_load(W + (size_t)(k0 + kk) * N + ncol0_src + (lane & 31)) : 0.f; }
#pragma unroll
      for (int i = 0; i < 32; ++i) { const int kk = 2 * i + (lane >> 5); scr[kk * 33 + (lane & 31)] = tv[i]; } }
    asm volatile("s_waitcnt lgkmcnt(0)" ::: "memory");
    const int cc = lane & 7;
#pragma unroll
    for (int j = 0; j < 4; ++j) { const int n = (lane >> 3) + 8 * j; const LAS float* s = scr + (8 * cc) * 33 + n;
        u32x4 o; o.x = pk_f16(s[0 * 33], s[1 * 33]); o.y = pk_f16(s[2 * 33], s[3 * 33]); o.z = pk_f16(s[4 * 33], s[5 * 33]); o.w = pk_f16(s[6 * 33], s[7 * 33]);
        *(u32x4*)(WT + (size_t)(dst_row0 + n) * K + k0 + 8 * cc) = o; }
    asm volatile("s_waitcnt lgkmcnt(0)" ::: "memory");
}

__device__ __forceinline__ void conv_weights_layer(Frame& F, CP& p, int l, int gw, int NGW, bool do_in = true, bool do_out = true) {
    u16* WINT = (u16*)(p.ws + WS_WINT); u16* WOUTT = (u16*)(p.ws + WS_WOUTT);
    LAS float* scr = (LAS float*)(F.lds + F.wave * 16384);
    constexpr int I_IN = 16 * (NP / 32), I_OUT = 16 * (D / 32);
    for (int it = gw + (do_in ? 0 : I_IN); it < (do_out ? I_IN + I_OUT : I_IN); it += NGW) { int r = it;
        if (r < I_IN) { const int kb = r / (NP / 32), nb = r % (NP / 32), n0 = nb * 32; int src = n0; bool valid = true;
            if (n0 >= DSH && n0 < PC_Q) { valid = false; src = 0; } else if (n0 >= PC_Q) src = n0 - 128;
            p0_transpose_item(p.w_in + (size_t)l * D * DIN, D, DIN, src, valid, WINT, n0, kb * 64, scr, F.lane); }
        else { r -= I_IN; const int kb = r / (D / 32), nb = r % (D / 32);
            p0_transpose_item(p.w_out + (size_t)l * D * D, D, D, nb * 32, true, WOUTT + (size_t)(l & 1) * D * D, nb * 32, kb * 64, scr, F.lane); } }
}
__device__ __forceinline__ void sw_layer(Frame& F, CP& p, int l, int g, int NG) {
    const float* MOD = (const float*)(p.ws + WS_MOD); float* SW = (float*)(p.ws + WS_SW) + (size_t)(l & 1) * 2 * SW_HALF;
    LAS float* vec = (LAS float*)F.lds;
    __syncthreads();
    for (int i = F.tid; i < 8 * 1024; i += NTHR) vec[i] = MOD[((size_t)l * 8 + (i >> 10)) * 3072 + (i & 1023)];
    __syncthreads();
    for (int it = g; it < 2 * (NP / 64); it += NG) { const int half = it & 1, nb = it >> 1;
        gemv8h_item(F, vec, p.w_in + (size_t)l * D * DIN, DIN, nb * 64, half, SW + (size_t)half * SW_HALF, NP); }
}
__device__ __forceinline__ void p0a_rest(Frame& F, CP& p) {
    conv_weights_layer(F, p, 0, F.bid * NWAVES + F.wave, F.G * NWAVES);
    u16* W2T = (u16*)(p.ws + WS_W2T); u16* A2T = (u16*)(p.ws + WS_A2T);
    for (int i = F.bid * NTHR + F.tid; i < NL * DR * 64; i += F.G * NTHR) { const int j = i & 63, c = (i >> 6) & 511, l = i >> 15;
        W2T[i] = f2h(p.w2[((size_t)l * 64 + j) * DR + c]); A2T[i] = f2h(p.a2[((size_t)l * 64 + j) * DR + c]); }
}
__device__ __forceinline__ void p0b(Frame& F, CP& p) {
    const float* MOD = (const float*)(p.ws + WS_MOD);
    sw_layer(F, p, 0, F.bid, F.G);
    { u16* AX = (u16*)(p.ws + WS_AX); float* PART = (float*)(p.ws + WS_PART);
      const int gw = F.bid * NWAVES + F.wave, NGW = F.G * NWAVES;
      for (int r0 = gw; r0 < M; r0 += 4 * NGW) {
          f32x4 xv[4][4];
#pragma unroll
          for (int q = 0; q < 4; ++q)
#pragma unroll
              for (int j = 0; j < 4; ++j) xv[q][j] = __builtin_nontemporal_load((const f32x4*)(p.x + (size_t)(r0 + q * NGW) * D + 4 * F.lane + 256 * j));
#pragma unroll
          for (int q = 0; q < 4; ++q) { const int r = r0 + q * NGW, b = r >> 11; float ss = 0.f;
#pragma unroll
              for (int j = 0; j < 4; ++j) { const int c = 4 * F.lane + 256 * j;
                  const f32x4 g = *(const f32x4*)(p.norm_g + c) * (1.0f + *(const f32x4*)(MOD + (size_t)b * 3072 + 1024 + c));
                  const f32x4 x4 = xv[q][j];
                  ss += (x4[0] * x4[0] + x4[1] * x4[1]) + (x4[2] * x4[2] + x4[3] * x4[3]);
                  const f32x4 a = x4 * g; u32x2 w; w.x = pk_f16(a[0], a[1]); w.y = pk_f16(a[2], a[3]);
                  *(u32x2*)(AX + (size_t)r * D + c) = w; }
              ss = wave_sum(ss);
              if (F.lane < 16) PART[(size_t)r * 16 + F.lane] = (F.lane == 0) ? ss : 0.f; } }
    }
}

__device__ __forceinline__ void p3_tables(Frame& F, CP& p, const pg8::StaticOrder& So, int l) {
    LAS float* gt = (LAS float*)(F.lds + LDS_RSTD); LAS float* Gt = gt + 256; const float* MOD = (const float*)(p.ws + WS_MOD);
    pg8::Unit u;
    if (So.next(0, u)) { const int b = u.pm >> 3, cc = F.tid & 255, col = u.pn * 256 + cc;
        if (F.tid < 256) gt[cc] = MOD[((size_t)l * 8 + b) * 3072 + 2048 + col];
        else Gt[cc] = (l + 1 < NL) ? p.norm_g[(l + 1) * D + col] * (1.0f + MOD[((size_t)(l + 1) * 8 + b) * 3072 + 1024 + col]) : 0.f; }
    __syncthreads();
}
__device__ __forceinline__ void p1_rstd(Frame& F, CP& p, const pg8::StaticOrder& So, int l) {
    LAS float* tab = (LAS float*)(F.lds + LDS_RSTD); const float* PART = (const float*)(p.ws + WS_PART);
    LAS float* svt = (LAS float*)(F.lds + LDS_SVT); const float* SW = (const float*)(p.ws + WS_SW) + (size_t)(l & 1) * 2 * SW_HALF;
    pg8::Unit u;
    for (int i = 0; So.next(i, u) && i < P1_MAXU; ++i) {
        if (F.tid >= 256) { const int cc = F.tid - 256; const size_t o = (size_t)(u.pm >> 3) * NP + u.pn * 256 + cc; svt[i * 256 + cc] = SW[o] + SW[SW_HALF + o]; }
        if (F.tid < 256) { const float* pr = PART + (size_t)(u.pm * 256 + F.tid) * 16; float s = 0.f;
#pragma unroll
            for (int j = 0; j < 4; ++j) { const f32x4 v = *(const f32x4*)(pr + 4 * j); s += (v[0] + v[1]) + (v[2] + v[3]); }
            tab[i * 256 + F.tid] = rsqrtf(s * (1.0f / D) + 1e-6f); }
    }
    __syncthreads();
}

typedef short s16x4 __attribute__((ext_vector_type(4)));
typedef short bf16x8 __attribute__((ext_vector_type(8)));
typedef float f32x16 __attribute__((ext_vector_type(16)));
typedef __bf16 bf16x2_t __attribute__((ext_vector_type(2)));
__device__ __forceinline__ unsigned pk_bf16(float lo, float hi) { f32x2 v = {lo, hi}; bf16x2_t b = __builtin_convertvector(v, bf16x2_t); return __builtin_bit_cast(unsigned, b); }
__device__ __forceinline__ s16x4 vtr(const LAS unsigned char* p) { return __builtin_bit_cast(s16x4, __builtin_amdgcn_ds_read_tr16_b64_v4i16((LAS s16x4*)p)); }
constexpr float LOG2E = 1.4426950408889634f;
constexpr int AT_K = 0, AT_V = 16384, AT_BIAS = 32768;

__device__ __forceinline__ void attn_wg_unit(Frame& F, CP& p, int l, int b, int h, int cgi, size_t yoff = WS_YB) {
    const u16* PROJ = (const u16*)(p.ws + WS_PROJ); u16* YO = (u16*)(p.ws + yoff);
    LAS unsigned char* L = F.lds; LAS float* bias2 = (LAS float*)(L + AT_BIAS);
    const int lane = F.lane, w = F.wave, q32 = lane & 31, hh = lane >> 5;
    const int n0 = cgi * 4, c = n0 + (w >> 1), qh = w & 1;
#ifdef APROBE
    unsigned long long aq[5] = {0, 0, 0, 0, 0}; unsigned long long at_ = __builtin_amdgcn_s_memrealtime(); const unsigned long long at0_ = at_;
#define AQ(k) do { const unsigned long long n_ = __builtin_amdgcn_s_memrealtime(); aq[k] += n_ - at_; at_ = n_; } while (0)
#else
#define AQ(k) do {} while (0)
#endif
    __syncthreads();
    if (F.tid < NREL) bias2[NREL - 1 - F.tid] = p.rel_bias[((size_t)l * NH + h) * NREL + F.tid] * LOG2E;
    const int tq = c * 64 + qh * 32 + q32; const size_t rq = (size_t)b * S + tq;
    f16x8 qf[4];
    { float qv[4][8]; float ss = 0.f;
#pragma unroll
      for (int s4 = 0; s4 < 4; ++s4) { const f16x8 v = *(const f16x8*)(PROJ + rq * NP + PC_Q + h * 64 + 16 * s4 + 8 * hh);
#pragma unroll
          for (int j = 0; j < 8; ++j) { qv[s4][j] = (float)v[j]; ss += qv[s4][j] * qv[s4][j]; } }
      ss = red_x32(ss);
      const float rs = rsqrtf(ss * (1.f / 64.f) + 1e-6f) * (0.125f * LOG2E);
#pragma unroll
      for (int s4 = 0; s4 < 4; ++s4) { const f32x4 g0 = *(const f32x4*)(p.qg + l * HD + 16 * s4 + 8 * hh), g1 = *(const f32x4*)(p.qg + l * HD + 16 * s4 + 8 * hh + 4);
          u32x4 wv; wv.x = pk_f16(qv[s4][0] * rs * g0[0], qv[s4][1] * rs * g0[1]); wv.y = pk_f16(qv[s4][2] * rs * g0[2], qv[s4][3] * rs * g0[3]);
          wv.z = pk_f16(qv[s4][4] * rs * g1[0], qv[s4][5] * rs * g1[1]); wv.w = pk_f16(qv[s4][6] * rs * g1[2], qv[s4][7] * rs * g1[3]);
          qf[s4] = __builtin_bit_cast(f16x8, wv); } }
    f32x16 O0, O1, cbv;
    { const float cb = p.rel_bias[((size_t)l * NH + h) * NREL + NREL - 1] * LOG2E;
#pragma unroll
      for (int r = 0; r < 16; ++r) { O0[r] = 0.f; O1[r] = 0.f; cbv[r] = cb; } }
    float lsum = 0.f;
    const int jlo = (n0 - 8 > 0) ? n0 - 8 : 0, jhi = n0 + 3;
    const int skey = F.tid >> 3, sch = F.tid & 7;
    const u16* kbase = PROJ + ((size_t)b * S + skey) * NP + PC_KA + h * 64 + sch * 8;
    const u16* vbase = PROJ + ((size_t)b * S + skey) * NP + PC_VA + h * 64 + sch * 8;
    const f32x4 kg0 = *(const f32x4*)(p.kg + l * HD + sch * 8), kg1 = *(const f32x4*)(p.kg + l * HD + sch * 8 + 4);
    u32x4 kreg = *(const u32x4*)(kbase + (size_t)jlo * 64 * NP), vreg = *(const u32x4*)(vbase + (size_t)jlo * 64 * NP);
    u32x4 kreg1 = kreg, vreg1 = vreg;
    if (jlo + 1 <= jhi) { kreg1 = *(const u32x4*)(kbase + (size_t)(jlo + 1) * 64 * NP); vreg1 = *(const u32x4*)(vbase + (size_t)(jlo + 1) * 64 * NP); }
    const int ti = lane & 15, tg16 = (lane >> 4) & 1;
    const int vrow = (4 * hh + (ti >> 2)) * 128, vsw = ((ti >> 3) & 1) << 6, vcol = 32 * tg16 + 8 * (ti & 3);
    AQ(4);
    f32x16 st[2];
    auto sm_pv = [&](int vb) {
        const LAS unsigned char* Vb = L + AT_V + vb * 8192 + vrow;
        s16x4 vl0[4], vh0[4], vl1[4], vh1[4];
#pragma unroll
        for (int s4 = 0; s4 < 4; ++s4) { vl0[s4] = vtr(Vb + s4 * 2048 + ((vcol) ^ vsw)); vh0[s4] = vtr(Vb + s4 * 2048 + 1024 + ((vcol) ^ vsw));
            vl1[s4] = vtr(Vb + s4 * 2048 + ((64 + vcol) ^ vsw)); vh1[s4] = vtr(Vb + s4 * 2048 + 1024 + ((64 + vcol) ^ vsw)); }
        __builtin_amdgcn_sched_barrier(0);
#pragma unroll
        for (int kb = 0; kb < 2; ++kb)
#pragma unroll
            for (int r = 0; r < 16; ++r) { const float pv = __builtin_amdgcn_exp2f(st[kb][r]); lsum += pv; st[kb][r] = pv; }
#pragma unroll
        for (int s4 = 0; s4 < 4; ++s4) { const int kb = s4 >> 1, r0 = 8 * (s4 & 1);
            u32x4 pw; pw.x = pk_bf16(st[kb][r0 + 0], st[kb][r0 + 1]); pw.y = pk_bf16(st[kb][r0 + 2], st[kb][r0 + 3]); pw.z = pk_bf16(st[kb][r0 + 4], st[kb][r0 + 5]); pw.w = pk_bf16(st[kb][r0 + 6], st[kb][r0 + 7]);
            const bf16x8 pa = __builtin_bit_cast(bf16x8, pw);
            { const bf16x8 vf = {vl0[s4][0], vl0[s4][1], vl0[s4][2], vl0[s4][3], vh0[s4][0], vh0[s4][1], vh0[s4][2], vh0[s4][3]};
              O0 = __builtin_amdgcn_mfma_f32_32x32x16_bf16(vf, pa, O0, 0, 0, 0); }
            { const bf16x8 vf = {vl1[s4][0], vl1[s4][1], vl1[s4][2], vl1[s4][3], vh1[s4][0], vh1[s4][1], vh1[s4][2], vh1[s4][3]};
              O1 = __builtin_amdgcn_mfma_f32_32x32x16_bf16(vf, pa, O1, 0, 0, 0); } }
    };
    auto qk = [&](const f32x16& c0, const f32x16& c1, const LAS unsigned char* Kb) {
        f16x8 kf_[2][4];
#pragma unroll
        for (int kb = 0; kb < 2; ++kb)
#pragma unroll
            for (int s4 = 0; s4 < 4; ++s4) kf_[kb][s4] = *(const LAS f16x8*)(Kb + (32 * kb + q32) * 128 + (((2 * s4 + hh) ^ (q32 & 7)) * 16));
        __builtin_amdgcn_sched_barrier(0);
        st[0] = __builtin_amdgcn_mfma_f32_32x32x16_f16(kf_[0][0], qf[0], c0, 0, 0, 0);
        st[1] = __builtin_amdgcn_mfma_f32_32x32x16_f16(kf_[1][0], qf[0], c1, 0, 0, 0);
#pragma unroll
        for (int s4 = 1; s4 < 4; ++s4) { st[0] = __builtin_amdgcn_mfma_f32_32x32x16_f16(kf_[0][s4], qf[s4], st[0], 0, 0, 0); st[1] = __builtin_amdgcn_mfma_f32_32x32x16_f16(kf_[1][s4], qf[s4], st[1], 0, 0, 0); }
    };
    f16x4 gpre[2][4];
    auto trip = [&](const int j, const bool lastf) {
        asm volatile("s_waitcnt lgkmcnt(0)" ::: "memory"); AQ(2);
        const int buf = j & 1;
        {
            const f16x8 kv = __builtin_bit_cast(f16x8, kreg); float kf[8]; float ss = 0.f;
#pragma unroll
            for (int e = 0; e < 8; ++e) { kf[e] = (float)kv[e]; ss += kf[e] * kf[e]; }
            ss += __builtin_bit_cast(float, __builtin_amdgcn_update_dpp(0, __builtin_bit_cast(int, ss), 0xB1, 0xf, 0xf, true));
            ss += __builtin_bit_cast(float, __builtin_amdgcn_update_dpp(0, __builtin_bit_cast(int, ss), 0x4E, 0xf, 0xf, true));
            ss += __builtin_bit_cast(float, __builtin_amdgcn_update_dpp(0, __builtin_bit_cast(int, ss), 0x141, 0xf, 0xf, true));
            const float rs = rsqrtf(ss * (1.f / 64.f) + 1e-6f);
            u32x4 kw; kw.x = pk_f16(kf[0] * rs * kg0[0], kf[1] * rs * kg0[1]); kw.y = pk_f16(kf[2] * rs * kg0[2], kf[3] * rs * kg0[3]);
            kw.z = pk_f16(kf[4] * rs * kg1[0], kf[5] * rs * kg1[1]); kw.w = pk_f16(kf[6] * rs * kg1[2], kf[7] * rs * kg1[3]);
            *(LAS u32x4*)(L + AT_K + buf * 8192 + skey * 128 + ((sch ^ (skey & 7)) * 16)) = kw;
            const f16x8 vv = __builtin_bit_cast(f16x8, vreg);
            u32x4 vw; vw.x = pk_bf16((float)vv[0], (float)vv[1]); vw.y = pk_bf16((float)vv[2], (float)vv[3]); vw.z = pk_bf16((float)vv[4], (float)vv[5]); vw.w = pk_bf16((float)vv[6], (float)vv[7]);
            *(LAS u32x4*)(L + AT_V + buf * 8192 + skey * 128 + ((sch * 16) ^ (((skey >> 1) & 1) << 6))) = vw;
        }
        kreg = kreg1; vreg = vreg1;
        if (j + 2 <= jhi) { kreg1 = *(const u32x4*)(kbase + (size_t)(j + 2) * 64 * NP); vreg1 = *(const u32x4*)(vbase + (size_t)(j + 2) * 64 * NP); }
        if (lastf) {
#pragma unroll
            for (int db = 0; db < 2; ++db)
#pragma unroll
                for (int r4 = 0; r4 < 4; ++r4) gpre[db][r4] = *(const f16x4*)(PROJ + rq * NP + PC_GA + h * 64 + 32 * db + 8 * r4 + 4 * hh); }
        asm volatile("s_waitcnt lgkmcnt(0)" ::: "memory"); AQ(0); __syncthreads(); AQ(1);
        if (j >= c - 8 && j <= c) {
            const int dc = c - j;
            const LAS unsigned char* Kb = L + AT_K + buf * 8192;
            if (dc >= 3) qk(cbv, cbv, Kb);
            else { f32x16 bi[2];
                if (dc < 2) {
                    const LAS float* br = bias2 + (NREL - 1) - (64 * dc + 32 * qh + q32 + 63 - 4 * hh);
#pragma unroll
                    for (int kb = 0; kb < 2; ++kb)
#pragma unroll
                        for (int r = 0; r < 16; ++r) bi[kb][r] = br[32 * kb + (r & 3) + 8 * (r >> 2)]; }
                else {
#pragma unroll
                    for (int kb = 0; kb < 2; ++kb)
#pragma unroll
                        for (int r = 0; r < 16; ++r) { const int keyloc = 32 * kb + (r & 3) + 8 * (r >> 2) + 4 * hh; int dist = 64 * dc + (32 * qh + q32) - keyloc; dist = dist > 128 ? 128 : dist; bi[kb][r] = bias2[128 - dist]; } }
                qk(bi[0], bi[1], Kb); }
            sm_pv(buf);
        }
    };
#pragma unroll 1
    for (int j = jlo; j < jhi; ++j) trip(j, false);
    trip(jhi, true);
    asm volatile("s_waitcnt lgkmcnt(0)" ::: "memory"); AQ(2);
    lsum = red_x32(lsum);
    const float inv = 1.f / lsum;
#pragma unroll
    for (int db = 0; db < 2; ++db)
#pragma unroll
        for (int r4 = 0; r4 < 4; ++r4) { const int d0 = 32 * db + 8 * r4 + 4 * hh;
            const f16x4 gq = gpre[db][r4];
            const float g0 = (float)gq[0], g1 = (float)gq[1], g2 = (float)gq[2], g3 = (float)gq[3];
            const float o0 = (db ? O1[4 * r4 + 0] : O0[4 * r4 + 0]) * inv, o1 = (db ? O1[4 * r4 + 1] : O0[4 * r4 + 1]) * inv, o2 = (db ? O1[4 * r4 + 2] : O0[4 * r4 + 2]) * inv, o3 = (db ? O1[4 * r4 + 3] : O0[4 * r4 + 3]) * inv;
            u32x2 ow; ow.x = pk_f16(o0 * g0 * sigmoidf_(g0), o1 * g1 * sigmoidf_(g1)); ow.y = pk_f16(o2 * g2 * sigmoidf_(g2), o3 * g3 * sigmoidf_(g3));
#ifdef FORCE_O1
            ow.x = pk_f16(g0, g1); ow.y = pk_f16(g2, g3);
#endif
#ifdef FORCE_CONST
            ow.x = pk_f16(0.25f, 0.25f); ow.y = ow.x;
#endif
            *(u32x2*)(YO + rq * D + DR + h * 64 + d0) = ow; }
#ifdef APROBE
    if (l == 2 && F.bid == 71 && w == 0 && lane == 0 && (b * 64 + h * 8 + cgi) == 7) {
        const float us = 0.01f * (float)(APROBE == 3 ? (__builtin_amdgcn_s_memrealtime() - at0_) : aq[APROBE]);
        *((float*)(p.ws + WS_CTL) + 1024) = 100.f * exp2f(0.25f * rintf(4.f * log2f(fmaxf(us, 0.01f)))); }
#endif
}


typedef _Float16 f16x4_t __attribute__((ext_vector_type(4)));
constexpr int RW_PITCH = 136;
constexpr int RW_W2T = 0, RW_A2T = 9216, RW_SLOT0 = 18432, RW_SLOT = 12800, RW_SCR0 = RW_SLOT0 + 8 * RW_SLOT, RW_SCR = 2176, RW_CONST = RW_SCR0 + 8 * RW_SCR;
constexpr int SL_WT = 0, SL_RH = 2176, SL_BB = 4352, SL_KB = 6528, SL_VV = 8704, SL_MUKT = 10880, SL_ARBT = 11392, SL_ARKT = 11904, SL_GAM = 12416, SL_BD = 12672;
enum { RC_MUR = 0, RC_MUK, RC_MUV, RC_MUG, RC_W0, RC_A0, RC_KK, RC_KA, RC_RK, RC_LG, RC_LB, RC_MUWD, RC_MUAD };
constexpr int RW_CONSTH = RW_CONST + 13 * 256;
static_assert(RW_CONSTH + 6 * 128 <= LDS_MISC, "rwkv LDS map");
static_assert(RW_SLOT0 + 8 * 10240 <= RW_SCR0 && IMG_BYTES <= 10240, "P2a image staging");
static_assert(LDS_SVT + P1_MAXU * 1024 <= LDS_MISC, "in-proj table LDS map");

__device__ __forceinline__ f32x4 mfma16(f16x4_t a, f16x4_t b, f32x4 c) { return __builtin_amdgcn_mfma_f32_16x16x16f16(a, b, c, 0, 0, 0); }
__device__ __forceinline__ f32x4 mfma32h(f16x8 a, f16x8 b, f32x4 c) { return __builtin_amdgcn_mfma_f32_16x16x32_f16(a, b, c, 0, 0, 0); }
__device__ __forceinline__ f16x4_t cvt4(f32x4 v) { u32x2 w; w.x = pk_f16(v[0], v[1]); w.y = pk_f16(v[2], v[3]); return __builtin_bit_cast(f16x4_t, w); }
__device__ __forceinline__ f16x8 cat8(f16x4_t a, f16x4_t b) { return (f16x8){a[0], a[1], a[2], a[3], b[0], b[1], b[2], b[3]}; }
__device__ __forceinline__ f16x4_t trr4(const LAS unsigned char* p) { return __builtin_bit_cast(f16x4_t, __builtin_amdgcn_ds_read_tr16_b64_v4i16((LAS s16x4*)p)); }
__device__ __forceinline__ f32x4 cf4(f16x4_t v) { return (f32x4){(float)v[0], (float)v[1], (float)v[2], (float)v[3]}; }
__device__ __forceinline__ float frcp(float x) { return __builtin_amdgcn_rcpf(x); }
__device__ __forceinline__ float fsig(float x) { return frcp(1.f + __expf(-x)); }
#define DPP_SHR(x, n, fillbits) __builtin_bit_cast(float, __builtin_amdgcn_update_dpp((int)(fillbits), __builtin_bit_cast(int, (x)), 0x110 + (n), 0xf, 0xf, false))

struct PreRegs { f16x4_t rc[4], kc[4]; f16x8 wc[2], ac[2]; };
struct CarryRegs { f16x4_t rp[4], kp[4]; f16x8 wp[2], ap[2]; };
__device__ __forceinline__ void rwkv_pre_load(Frame& F, CP& p, int b, int h, int ch, PreRegs& R) {
    const u16* PROJ = (const u16*)(p.ws + WS_PROJ);
    const int lane = F.lane, t = lane & 15, g4 = lane >> 4;
    const u16* pr = PROJ + ((size_t)b * S + ch * 16 + t) * NP;
#pragma unroll
    for (int jt = 0; jt < 4; ++jt) { const int col = h * 64 + 16 * jt + 4 * g4; R.rc[jt] = *(const f16x4_t*)(pr + PC_R + col); R.kc[jt] = *(const f16x4_t*)(pr + PC_K + col); }
#pragma unroll
    for (int ks = 0; ks < 2; ++ks) { const int cj = 32 * ks + 8 * g4; R.wc[ks] = *(const f16x8*)(pr + PC_WD + cj); R.ac[ks] = *(const f16x8*)(pr + PC_AD + cj); }
}
__device__ __forceinline__ void rwkv_carry_load(Frame& F, CP& p, int b, int h, int ch, CarryRegs& Cr) {
    const u16* PROJ = (const u16*)(p.ws + WS_PROJ);
    const int g4 = F.lane >> 4;
    const f16x4_t z4 = {(_Float16)0.f, (_Float16)0.f, (_Float16)0.f, (_Float16)0.f};
    f16x8 z8;
#pragma unroll
    for (int e = 0; e < 8; ++e) z8[e] = (_Float16)0.f;
    const bool hp = ch > 0;
    const u16* pr = PROJ + ((size_t)b * S + (hp ? ch * 16 - 1 : 0)) * NP;
#pragma unroll
    for (int jt = 0; jt < 4; ++jt) { const int col = h * 64 + 16 * jt + 4 * g4; Cr.rp[jt] = hp ? *(const f16x4_t*)(pr + PC_R + col) : z4; Cr.kp[jt] = hp ? *(const f16x4_t*)(pr + PC_K + col) : z4; }
#pragma unroll
    for (int ks = 0; ks < 2; ++ks) { const int cj = 32 * ks + 8 * g4; Cr.wp[ks] = hp ? *(const f16x8*)(pr + PC_WD + cj) : z8; Cr.ap[ks] = hp ? *(const f16x8*)(pr + PC_AD + cj) : z8; }
}
struct VGRegs { f16x4_t vc[4], gc[4]; };
struct VGCarry { f16x4_t vp[4], gp[4]; };
struct ImgRegs { u32x4 q[10]; };
__device__ __forceinline__ void rwkv_vg_load(Frame& F, CP& p, int b, int h, int ch, VGRegs& V) {
    const u16* PROJ = (const u16*)(p.ws + WS_PROJ);
    const int lane = F.lane, t = lane & 15, g4 = lane >> 4;
    const u16* pr = PROJ + ((size_t)b * S + ch * 16 + t) * NP;
#pragma unroll
    for (int it = 0; it < 4; ++it) { const int col = h * 64 + 16 * it + 4 * g4; V.vc[it] = *(const f16x4_t*)(pr + PC_V + col); V.gc[it] = *(const f16x4_t*)(pr + PC_G + col); }
}
__device__ __forceinline__ void rwkv_vg_carry(Frame& F, CP& p, int b, int h, int ch, VGCarry& C) {
    const u16* PROJ = (const u16*)(p.ws + WS_PROJ);
    const int g4 = F.lane >> 4; const bool hp = ch > 0;
    const f16x4_t z4 = {(_Float16)0.f, (_Float16)0.f, (_Float16)0.f, (_Float16)0.f};
    const u16* pr = PROJ + ((size_t)b * S + (hp ? ch * 16 - 1 : 0)) * NP;
#pragma unroll
    for (int it = 0; it < 4; ++it) { const int col = h * 64 + 16 * it + 4 * g4; C.vp[it] = hp ? *(const f16x4_t*)(pr + PC_V + col) : z4; C.gp[it] = hp ? *(const f16x4_t*)(pr + PC_G + col) : z4; }
}
__device__ __forceinline__ void img_load(const unsigned char* img, ImgRegs& I, int lane) {
    const unsigned char* q0 = img + lane * 16;
#pragma unroll
    for (int i = 0; i < 9; ++i) I.q[i] = __builtin_nontemporal_load((const u32x4*)(q0 + i * 1024));
    I.q[9] = (lane < IMG_BYTES / 16 - 576) ? __builtin_nontemporal_load((const u32x4*)(q0 + 9 * 1024)) : (u32x4){0u, 0u, 0u, 0u};
}
struct ImgOffs { int o[10]; };
__device__ __forceinline__ void img_offs(ImgOffs& Of, int lane) {
#pragma unroll
    for (int i = 0; i < 10; ++i) { const int pc = lane + 64 * i; Of.o[i] = pc < 512 ? ((pc >> 7) * 2176 + ((pc >> 3) & 15) * RW_PITCH + (pc & 7) * 16) : (SL_MUKT + (pc - 512) * 16); }
}
__device__ __forceinline__ void img_to_slot2(LAS unsigned char* slot, const ImgRegs& I, const ImgOffs& Of, int lane) {
#pragma unroll
    for (int i = 0; i < 10; ++i) { if (i < 9 || lane < IMG_BYTES / 16 - 576) {
            u32x2 lo, hi; lo.x = I.q[i].x; lo.y = I.q[i].y; hi.x = I.q[i].z; hi.y = I.q[i].w;
            *(LAS u32x2*)(slot + Of.o[i]) = lo; *(LAS u32x2*)(slot + Of.o[i] + 8) = hi; } }
}
__device__ __forceinline__ void img_to_slot(LAS unsigned char* slot, const ImgRegs& I, int lane) {
#pragma unroll
    for (int i = 0; i < 10; ++i) { const int pc = lane + 64 * i;
        if (pc < IMG_BYTES / 16) { const int off = pc < 512 ? ((pc >> 7) * 2176 + ((pc >> 3) & 15) * RW_PITCH + (pc & 7) * 16) : (SL_MUKT + (pc - 512) * 16);
            u32x2 lo, hi; lo.x = I.q[i].x; lo.y = I.q[i].y; hi.x = I.q[i].z; hi.y = I.q[i].w;
            *(LAS u32x2*)(slot + off) = lo; *(LAS u32x2*)(slot + off + 8) = hi; } }
}
__device__ __forceinline__ f16x4_t prev4(f16x4_t cur, f16x4_t carry) {
    const u32x2 c = __builtin_bit_cast(u32x2, cur), k = __builtin_bit_cast(u32x2, carry); u32x2 r;
    r.x = (unsigned)__builtin_amdgcn_update_dpp((int)k.x, (int)c.x, 0x111, 0xf, 0xf, false); r.y = (unsigned)__builtin_amdgcn_update_dpp((int)k.y, (int)c.y, 0x111, 0xf, 0xf, false);
    return __builtin_bit_cast(f16x4_t, r);
}
__device__ __forceinline__ f16x8 prev8(f16x8 cur, f16x8 carry) {
    const u32x4 c = __builtin_bit_cast(u32x4, cur), k = __builtin_bit_cast(u32x4, carry); u32x4 r;
    r.x = (unsigned)__builtin_amdgcn_update_dpp((int)k.x, (int)c.x, 0x111, 0xf, 0xf, false); r.y = (unsigned)__builtin_amdgcn_update_dpp((int)k.y, (int)c.y, 0x111, 0xf, 0xf, false);
    r.z = (unsigned)__builtin_amdgcn_update_dpp((int)k.z, (int)c.z, 0x111, 0xf, 0xf, false); r.w = (unsigned)__builtin_amdgcn_update_dpp((int)k.w, (int)c.w, 0x111, 0xf, 0xf, false);
    return __builtin_bit_cast(f16x8, r);
}
__device__ __forceinline__ void rwkv_pre(Frame& F, CP& p, int b, int h, int ch, const PreRegs& R, const CarryRegs& Cr, LAS unsigned char* img  , LAS unsigned char* scr) {
    const LAS unsigned char* L = F.lds; const LAS float* RC = (const LAS float*)(L + RW_CONST);
    const int lane = F.lane, t = lane & 15, g4 = lane >> 4;
    float r_[4][4], k_[4][4];
    const LAS unsigned char* RH_ = L + RW_CONSTH;
#pragma unroll
    for (int jt = 0; jt < 4; ++jt) { const int cj = 16 * jt + 4 * g4;
        const f16x4_t mr = *(const LAS f16x4_t*)(RH_ + 0 * 128 + cj * 2), mk = *(const LAS f16x4_t*)(RH_ + 1 * 128 + cj * 2);
        const f16x4_t rs = R.rc[jt] + mr * (prev4(R.rc[jt], Cr.rp[jt]) - R.rc[jt]), ks = R.kc[jt] + mk * (prev4(R.kc[jt], Cr.kp[jt]) - R.kc[jt]);
#pragma unroll
        for (int e = 0; e < 4; ++e) { r_[jt][e] = (float)rs[e]; k_[jt][e] = (float)ks[e]; } }
    f16x8 twd[2], adf[2];
#pragma unroll
    for (int ks = 0; ks < 2; ++ks) { const int cj = 32 * ks + 8 * g4;
        const f16x8 mw = *(const LAS f16x8*)(RH_ + 4 * 128 + cj * 2), ma = *(const LAS f16x8*)(RH_ + 5 * 128 + cj * 2);
        const f16x8 wsh = R.wc[ks] + mw * (prev8(R.wc[ks], Cr.wp[ks]) - R.wc[ks]);
        adf[ks] = R.ac[ks] + ma * (prev8(R.ac[ks], Cr.ap[ks]) - R.ac[ks]);
        float wv[8];
#pragma unroll
        for (int q = 0; q < 8; ++q) { const float ex = __expf(2.f * (float)wsh[q]); wv[q] = 1.f - 2.f * frcp(ex + 1.f); }
        u32x4 tw; tw.x = pk_f16(wv[0], wv[1]); tw.y = pk_f16(wv[2], wv[3]); tw.z = pk_f16(wv[4], wv[5]); tw.w = pk_f16(wv[6], wv[7]);
        twd[ks] = __builtin_bit_cast(f16x8, tw); }
    float lw_[4][4], al_[4][4];
#pragma unroll
    for (int ct = 0; ct < 4; ++ct) { f32x4 aw = {0.f, 0.f, 0.f, 0.f}, aa = aw;
#pragma unroll
        for (int ks = 0; ks < 2; ++ks) { const int off = (16 * ct + t) * 144 + (32 * ks + 8 * g4) * 2;
            aw = mfma32h(*(const LAS f16x8*)(L + RW_W2T + off), twd[ks], aw); aa = mfma32h(*(const LAS f16x8*)(L + RW_A2T + off), adf[ks], aa); }
        const int cj = 16 * ct + 4 * g4;
        const f32x4 w0v = *(const LAS f32x4*)(RC + RC_W0 * 64 + cj), a0v = *(const LAS f32x4*)(RC + RC_A0 * 64 + cj);
#pragma unroll
        for (int e = 0; e < 4; ++e) { lw_[ct][e] = -0.6065306597126334f * fsig(w0v[e] + aw[e]); al_[ct][e] = fsig(a0v[e] + aa[e]); } }
    float kk_[4][4], k2_[4][4]; float ss = 0.f, bd = 0.f;
#pragma unroll
    for (int jt = 0; jt < 4; ++jt) { const int cj = 16 * jt + 4 * g4;
        const f32x4 kkv = *(const LAS f32x4*)(RC + RC_KK * 64 + cj), kav = *(const LAS f32x4*)(RC + RC_KA * 64 + cj), rkv = *(const LAS f32x4*)(RC + RC_RK * 64 + cj);
#pragma unroll
        for (int e = 0; e < 4; ++e) { const float kk = k_[jt][e] * kkv[e]; kk_[jt][e] = kk; ss += kk * kk;
            const float k2 = k_[jt][e] * (1.f + (al_[jt][e] - 1.f) * kav[e]); k2_[jt][e] = k2; bd += r_[jt][e] * k2 * rkv[e]; } }
    ss = red_rows(ss); bd = red_rows(bd);
    const float rn = 1.f / fmaxf(sqrtf(ss), 1e-12f);
    if (g4 == 0) ((float*)(p.ws + WS_BDG))[((size_t)b * S + ch * 16 + t) * 8 + h] = bd;
    f16x4_t Ahp[4], Rhp[4], Bcp[4], Kcp[4];
    float E1_[4][4], gam_[4][4];
#pragma unroll
    for (int jt = 0; jt < 4; ++jt)
#pragma unroll
        for (int e = 0; e < 4; ++e) { float G = lw_[jt][e];
            G += DPP_SHR(G, 1, 0); G += DPP_SHR(G, 2, 0); G += DPP_SHR(G, 4, 0); G += DPP_SHR(G, 8, 0);
            E1_[jt][e] = __expf(G); }
#pragma unroll
    for (int jt = 0; jt < 4; ++jt)
#pragma unroll
        for (int e = 0; e < 4; ++e) gam_[jt][e] = __builtin_bit_cast(float, __builtin_amdgcn_ds_bpermute(((lane & 48) | 15) << 2, __builtin_bit_cast(int, E1_[jt][e])));
#pragma unroll
    for (int jt = 0; jt < 4; ++jt) { f32x4 ah, rh, bc, kc, bb, kb, gm;
#pragma unroll
        for (int e = 0; e < 4; ++e) { const float E1 = E1_[jt][e]; const float E0 = DPP_SHR(E1, 1, 0x3f800000); const float Ei = frcp(E1);
            const float gam = gam_[jt][e];
            const float E2 = gam * Ei; const float a = -kk_[jt][e] * rn, bq = -a * al_[jt][e];
            ah[e] = a * E0; rh[e] = r_[jt][e] * E1; bc[e] = bq * Ei; kc[e] = k2_[jt][e] * Ei; bb[e] = bq * E2; kb[e] = k2_[jt][e] * E2; gm[e] = gam; }
        Ahp[jt] = cvt4(ah); Rhp[jt] = cvt4(rh); Bcp[jt] = cvt4(bc); Kcp[jt] = cvt4(kc);
        const int o = t * RW_PITCH + (16 * jt + 4 * g4) * 2, og = t * 128 + (16 * jt + 4 * g4) * 2;
        *(LAS f16x4_t*)(scr + o) = Ahp[jt]; *(LAS f16x4_t*)(img + IM_RH + og) = Rhp[jt]; *(LAS f16x4_t*)(img + IM_BB + og) = cvt4(bb); *(LAS f16x4_t*)(img + IM_KB + og) = cvt4(kb);
        if (t == 15) *(LAS f32x4*)(img + IM_GAM + (16 * jt + 4 * g4) * 4) = gm; }
    const f32x4 Z = {0.f, 0.f, 0.f, 0.f};
    f32x4 Aab = Z, AabT = Z, Aak = Z, ArbT = Z, ArkT = Z;
#pragma unroll
    for (int ks = 0; ks < 2; ++ks) { const f16x8 ah = cat8(Ahp[2 * ks], Ahp[2 * ks + 1]), rh = cat8(Rhp[2 * ks], Rhp[2 * ks + 1]), bc = cat8(Bcp[2 * ks], Bcp[2 * ks + 1]), kc = cat8(Kcp[2 * ks], Kcp[2 * ks + 1]);
        Aab = mfma32h(ah, bc, Aab); AabT = mfma32h(bc, ah, AabT); Aak = mfma32h(ah, kc, Aak); ArbT = mfma32h(bc, rh, ArbT); ArkT = mfma32h(kc, rh, ArkT); }
    f32x4 Q;
#pragma unroll
    for (int rr = 0; rr < 4; ++rr) { const int row4 = 4 * g4 + rr;
        Aab[rr] = (t < row4) ? Aab[rr] : 0.f; Aak[rr] = (t < row4) ? Aak[rr] : 0.f;
        AabT[rr] = (row4 < t) ? AabT[rr] : 0.f;
        ArbT[rr] = (row4 <= t) ? ArbT[rr] : 0.f; ArkT[rr] = (row4 <= t) ? ArkT[rr] : 0.f;
        Q[rr] = AabT[rr] + ((row4 == t) ? 1.f : 0.f); }
    const f16x4_t x = cvt4(Aab), xt = cvt4(AabT);
    const f32x4 A2 = mfma16(xt, x, Z), A2t = mfma16(x, xt, Z);
    const f16x4_t a2 = cvt4(A2), a2t = cvt4(A2t);
    const f32x4 A4 = mfma16(a2t, a2, Z), A4t = mfma16(a2, a2t, Z);
    const f16x4_t a4 = cvt4(A4), a4t = cvt4(A4t);
    const f32x4 A8 = mfma16(a4t, a4, Z);
    Q = mfma16(a2, cvt4(Q), Q); Q = mfma16(a4, cvt4(Q), Q); Q = mfma16(cvt4(A8), cvt4(Q), Q);
    const f16x4_t tt = cvt4(Q);
    const int tro = (4 * g4 + (t >> 2)) * RW_PITCH + 8 * (t & 3);
#pragma unroll
    for (int jt = 0; jt < 4; ++jt) { const f32x4 wt = mfma16(trr4(scr + tro + 32 * jt), tt, Z);
        *(LAS f16x4_t*)(img + IM_WT + t * 128 + (16 * jt + 4 * g4) * 2) = cvt4(wt); }
    *(LAS f16x4_t*)(img + IM_MUKT + lane * 8) = cvt4(mfma16(cvt4(Aak), tt, Z));
    *(LAS f16x4_t*)(img + IM_ARBT + lane * 8) = cvt4(ArbT);
    *(LAS f16x4_t*)(img + IM_ARKT + lane * 8) = cvt4(ArkT);
}

struct ChainOps { f16x4_t wt[4], rh[4], mukt, arbt, arkt, vf, bbt[4], kbt[4]; f32x4 gm[4]; };
__device__ __forceinline__ void chain_ops_load(ChainOps& O, const LAS unsigned char* slot, int it, int tro, int l1o, int lane, int g4) {
#pragma unroll
    for (int jt = 0; jt < 4; ++jt) { O.wt[jt] = *(const LAS f16x4_t*)(slot + SL_WT + l1o + 32 * jt); O.rh[jt] = *(const LAS f16x4_t*)(slot + SL_RH + l1o + 32 * jt);
        O.bbt[jt] = trr4(slot + SL_BB + tro + 32 * jt); O.kbt[jt] = trr4(slot + SL_KB + tro + 32 * jt); O.gm[jt] = *(const LAS f32x4*)(slot + SL_GAM + (16 * jt + 4 * g4) * 4); }
    O.mukt = *(const LAS f16x4_t*)(slot + SL_MUKT + lane * 8); O.arbt = *(const LAS f16x4_t*)(slot + SL_ARBT + lane * 8); O.arkt = *(const LAS f16x4_t*)(slot + SL_ARKT + lane * 8);
    O.vf = trr4(slot + SL_VV + tro + 32 * it);
}
template <int NC> __device__ __forceinline__ void rwkv_chainN(Frame& F, f32x4 (&st)[4], const LAS unsigned char* slot0, u16* yrow0, int it) {
    const int lane = F.lane, t = lane & 15, g4 = lane >> 4;
    const f32x4 Z = {0.f, 0.f, 0.f, 0.f};
    const int tro = (4 * g4 + (t >> 2)) * RW_PITCH + 8 * (t & 3), l1o = t * RW_PITCH + 8 * g4;
    ChainOps O; chain_ops_load(O, slot0, it, tro, l1o, lane, g4);
#pragma unroll
    for (int cc = 0; cc < NC; ++cc) {
        ChainOps N;
        if (cc + 1 < NC) chain_ops_load(N, slot0 + (cc + 1) * RW_SLOT, it, tro, l1o, lane, g4); else N = O;
        const f16x8 sb0 = cat8(cvt4(st[0]), cvt4(st[1])), sb1 = cat8(cvt4(st[2]), cvt4(st[3]));
        f32x4 U = mfma16(O.mukt, O.vf, Z);
        U = mfma32h(cat8(O.wt[0], O.wt[1]), sb0, U); U = mfma32h(cat8(O.wt[2], O.wt[3]), sb1, U);
        const f16x4_t uf = cvt4(U); const f16x8 uv = cat8(uf, O.vf);
#pragma unroll
        for (int jt = 0; jt < 4; ++jt) st[jt] = mfma32h(cat8(O.bbt[jt], O.kbt[jt]), uv, st[jt] * O.gm[jt]);
        f32x4 Y = mfma32h(sb0, cat8(O.rh[0], O.rh[1]), Z); Y = mfma32h(sb1, cat8(O.rh[2], O.rh[3]), Y);
        Y = mfma32h(uv, cat8(O.arbt, O.arkt), Y);
        *(f16x4_t*)(yrow0 + (size_t)(cc * 16 + t) * D + 16 * it + 4 * g4) = cvt4(Y);
        O = N;
        __builtin_amdgcn_sched_barrier(0);
    }
}

__device__ __forceinline__ void rwkv_vv_build(Frame& F, const VGRegs& V, const VGCarry& C, LAS unsigned char* slot) {
    const int lane = F.lane, t = lane & 15, g4 = lane >> 4;
#pragma unroll
    for (int it = 0; it < 4; ++it) { const int ci = 16 * it + 4 * g4;
        const f16x4_t mv = *(const LAS f16x4_t*)(F.lds + RW_CONSTH + 2 * 128 + ci * 2);
        *(LAS f16x4_t*)(slot + SL_VV + t * RW_PITCH + ci * 2) = V.vc[it] + mv * (prev4(V.vc[it], C.vp[it]) - V.vc[it]); }
}
__device__ __forceinline__ void rwkv_post(Frame& F, CP& p, int b, int h, int ch, const VGRegs& G, const VGCarry& Cr, const LAS unsigned char* slot, const LAS unsigned char* ybuf) {
    u16* YO = (u16*)(p.ws + WS_YB);
    const LAS float* RC = (const LAS float*)(F.lds + RW_CONST);
    const int lane = F.lane, t = lane & 15, g4 = lane >> 4;
    const size_t row = (size_t)b * S + ch * 16 + t;
    f32x4 y[4]; float s1 = 0.f;
#pragma unroll
    for (int it = 0; it < 4; ++it) { y[it] = cf4(*(const LAS f16x4_t*)(ybuf + t * RW_PITCH + (16 * it + 4 * g4) * 2)); s1 += (y[it][0] + y[it][1]) + (y[it][2] + y[it][3]); }
    s1 = red_rows(s1);
    const float mean = s1 * (1.f / 64.f); float s2 = 0.f;
#pragma unroll
    for (int it = 0; it < 4; ++it) { y[it] = y[it] - mean; s2 += (y[it][0] * y[it][0] + y[it][1] * y[it][1]) + (y[it][2] * y[it][2] + y[it][3] * y[it][3]); }
    s2 = red_rows(s2);
    const float rstd = rsqrtf(s2 * (1.f / 64.f) + 64e-5f);
    const float bd = *(const LAS float*)(slot + SL_BD + t * 4);
#pragma unroll
    for (int it = 0; it < 4; ++it) { const int ci = 16 * it + 4 * g4, col = h * 64 + ci;
        const f32x4 lg = *(const LAS f32x4*)(RC + RC_LG * 64 + ci), lb = *(const LAS f32x4*)(RC + RC_LB * 64 + ci);
        const f32x4 v = cf4(*(const LAS f16x4_t*)(slot + SL_VV + t * RW_PITCH + ci * 2));
        const f16x4_t mgh = *(const LAS f16x4_t*)(F.lds + RW_CONSTH + 3 * 128 + ci * 2);
        const f32x4 g = cf4(G.gc[it] + mgh * (prev4(G.gc[it], Cr.gp[it]) - G.gc[it]));
        f32x4 o;
#pragma unroll
        for (int e = 0; e < 4; ++e) { const float yn = y[it][e] * rstd * lg[e] + lb[e] + bd * v[e]; o[e] = yn * g[e] * fsig(g[e]); }
        *(f16x4_t*)(YO + row * D + col) = cvt4(o); }
}

__device__ __forceinline__ void rwkv_tables(Frame& F, CP& p, int l, int h, bool lora) {
    LAS unsigned char* L = F.lds; LAS float* RC = (LAS float*)(L + RW_CONST);
    for (int i = F.tid; i < 13 * 64; i += NTHR) { const int a = i >> 6, c = i & 63; float v;
        switch (a) { case RC_MUR: v = p.mu[l * DSH + PC_R + h * 64 + c]; break; case RC_MUK: v = p.mu[l * DSH + PC_K + h * 64 + c]; break; case RC_MUV: v = p.mu[l * DSH + PC_V + h * 64 + c]; break;
            case RC_MUG: v = p.mu[l * DSH + PC_G + h * 64 + c]; break; case RC_W0: v = p.w0[l * DR + h * 64 + c]; break; case RC_A0: v = p.a0[l * DR + h * 64 + c]; break;
            case RC_KK: v = p.k_k[l * DR + h * 64 + c]; break; case RC_KA: v = p.k_a[l * DR + h * 64 + c]; break; case RC_RK: v = p.r_k[l * DR + h * 64 + c]; break;
            case RC_LG: v = p.lnx_g[l * DR + h * 64 + c]; break; case RC_LB: v = p.lnx_b[l * DR + h * 64 + c]; break; case RC_MUWD: v = p.mu[l * DSH + PC_WD + c]; break; default: v = p.mu[l * DSH + PC_AD + c]; break; }
        RC[i] = v;
        if (a <= RC_MUG) ((LAS u16*)(L + RW_CONSTH))[a * 64 + c] = f2h(v); else if (a >= RC_MUWD) ((LAS u16*)(L + RW_CONSTH))[(4 + a - RC_MUWD) * 64 + c] = f2h(v); }
    if (lora) { const u16* w2t = (const u16*)(p.ws + WS_W2T) + ((size_t)l * DR + h * 64) * 64; const u16* a2t = (const u16*)(p.ws + WS_A2T) + ((size_t)l * DR + h * 64) * 64;
        const int c = F.tid >> 3, q = F.tid & 7;
        *(LAS u32x4*)(L + RW_W2T + c * 144 + q * 16) = *(const u32x4*)(w2t + c * 64 + q * 8); *(LAS u32x4*)(L + RW_A2T + c * 144 + q * 16) = *(const u32x4*)(a2t + c * 64 + q * 8); }
    __syncthreads();
}
__device__ __forceinline__ void p2a_rwkv_pre(Frame& F, CP& p, int l) {
    const int bh = (F.bid & 7) | (((F.bid >> 3) & 7) << 3), b = bh >> 3, h = bh & 7, c0 = (F.bid >> 6) * 32, w = F.wave;
    rwkv_tables(F, p, l, h, true);
    LAS unsigned char* scr = F.lds + RW_SCR0 + w * RW_SCR;
    LAS unsigned char* stg = F.lds + RW_SLOT0 + w * 10240;
    PreRegs R; rwkv_pre_load(F, p, b, h, c0 + w, R);
#pragma unroll 1
    for (int i = 0; i < 4; ++i) { const int ch = c0 + 8 * i + w;
        { int ln_ = F.lane; asm volatile("" : "+v"(ln_)); F.lane = ln_; }
        if (i == 2 && w >= 4) __builtin_amdgcn_s_setprio(1);
        CarryRegs Cr; rwkv_carry_load(F, p, b, h, ch, Cr);
        rwkv_pre(F, p, b, h, ch, R, Cr, stg, scr);
        { asm volatile("s_waitcnt lgkmcnt(0)" ::: "memory");
          unsigned char* gi = img_ptr(p.ws, bh * 128 + ch) + F.lane * 16; const LAS unsigned char* si = stg + F.lane * 16;
#pragma unroll
          for (int i = 0; i < 10; ++i) if (i < 9 || F.lane < IMG_BYTES / 16 - 576) st16_wt(gi + i * 1024, *(const LAS u32x4*)(si + i * 1024)); }
        if (i + 1 < 4) rwkv_pre_load(F, p, b, h, ch + 8, R); }
    __builtin_amdgcn_s_setprio(0);
}
struct HChunk { u32x4 q[10]; u32x2 v[4], c[4]; };
#define HC_LOADS 18
#define HL16(dst, ptr, off) asm volatile("global_load_dwordx4 %0, %1, off offset:" #off " nt" : "=v"(dst) : "v"(ptr))
#define HL8(dst, ptr, off) asm volatile("global_load_dwordx2 %0, %1, off offset:" #off : "=v"(dst) : "v"(ptr))
__device__ __forceinline__ void h_issue(HChunk& R, CP& p, int bh, int ch, int lane) {
    const unsigned char* q0 = img_ptr(p.ws, bh * 128 + ch) + lane * 16; const unsigned char* q1 = q0 + 4096; const unsigned char* q2 = q0 + 8192;
    const unsigned char* q3 = q0 + ((lane < IMG_BYTES / 16 - 576) ? 9216 : 8192);
    HL16(R.q[0], q0, 0); HL16(R.q[1], q0, 1024); HL16(R.q[2], q0, 2048); HL16(R.q[3], q0, 3072);
    HL16(R.q[4], q1, 0); HL16(R.q[5], q1, 1024); HL16(R.q[6], q1, 2048); HL16(R.q[7], q1, 3072);
    HL16(R.q[8], q2, 0); HL16(R.q[9], q3, 0);
    const int t = lane & 15, g4 = lane >> 4; const u16* PROJ = (const u16*)(p.ws + WS_PROJ);
    const u16* pv = PROJ + ((size_t)(bh >> 3) * S + ch * 16 + t) * NP + PC_V + (bh & 7) * 64 + 4 * g4;
    const u16* pc = PROJ + ((size_t)(bh >> 3) * S + (ch > 0 ? ch * 16 - 1 : 0)) * NP + PC_V + (bh & 7) * 64 + 4 * g4;
    HL8(R.v[0], pv, 0); HL8(R.v[1], pv, 32); HL8(R.v[2], pv, 64); HL8(R.v[3], pv, 96);
    HL8(R.c[0], pc, 0); HL8(R.c[1], pc, 32); HL8(R.c[2], pc, 64); HL8(R.c[3], pc, 96);
}
#define H_WAIT(R, N) asm volatile("s_waitcnt vmcnt(" #N ")" : "+v"(R.q[0]), "+v"(R.q[1]), "+v"(R.q[2]), "+v"(R.q[3]), "+v"(R.q[4]), "+v"(R.q[5]), "+v"(R.q[6]), "+v"(R.q[7]), "+v"(R.q[8]), "+v"(R.q[9]), \
        "+v"(R.v[0]), "+v"(R.v[1]), "+v"(R.v[2]), "+v"(R.v[3]), "+v"(R.c[0]), "+v"(R.c[1]), "+v"(R.c[2]), "+v"(R.c[3]) :: "memory")
__device__ __forceinline__ void h_store(Frame& F, const HChunk& R, LAS unsigned char* slot, bool hp, const f16x4_t (&mvr)[4]) {
    const int lane = F.lane, t = lane & 15, g4 = lane >> 4;
    LAS unsigned char* s0 = slot + (lane >> 3) * RW_PITCH + (lane & 7) * 16; LAS unsigned char* s1 = slot + SL_MUKT + lane * 16;
#pragma unroll
    for (int i = 0; i < 10; ++i) { if (i < 9 || lane < IMG_BYTES / 16 - 576) {
            u32x2 lo, hi; lo.x = R.q[i].x; lo.y = R.q[i].y; hi.x = R.q[i].z; hi.y = R.q[i].w;
            LAS unsigned char* d = i < 8 ? s0 + (i >> 1) * 2176 + (i & 1) * 8 * RW_PITCH : s1 + (i - 8) * 1024;
            *(LAS u32x2*)d = lo; *(LAS u32x2*)(d + 8) = hi; } }
    const f16x4_t z4 = {(_Float16)0.f, (_Float16)0.f, (_Float16)0.f, (_Float16)0.f};
#pragma unroll
    for (int it = 0; it < 4; ++it) { const int ci = 16 * it + 4 * g4;
        const f16x4_t vc = __builtin_bit_cast(f16x4_t, R.v[it]), vp = hp ? __builtin_bit_cast(f16x4_t, R.c[it]) : z4;
        *(LAS f16x4_t*)(slot + SL_VV + t * RW_PITCH + ci * 2) = vc + mvr[it] * (prev4(vc, vp) - vc); }
}

__device__ __forceinline__ void rwkv_unit_chain(Frame& F, CP& p, int l, int b, int h) {
    LAS unsigned char* L = F.lds;
#ifdef CPROBE
    unsigned long long cq[3] = {0, 0, 0}; unsigned long long ct_ = __builtin_amdgcn_s_memrealtime();
#define CQ(k) do { const unsigned long long n_ = __builtin_amdgcn_s_memrealtime(); cq[k] += n_ - ct_; ct_ = n_; } while (0)
#ifndef CPQ
#define CPQ 8.f
#endif
#ifndef CPOFF
#define CPOFF 0.f
#endif
#define CQ_OUT(wsel, k, id) do { if (CPROBE == (id) && l == 1 && F.bid == 0 && F.wave == (wsel) && F.lane == 0) { const float us = 0.01f * (float)cq[k]; *((float*)(p.ws + WS_CTL) + 1024) = 1.f + floorf((us + CPOFF) / CPQ); } } while (0)
#else
#define CQ(k) do {} while (0)
#define CQ_OUT(wsel, k, id) do {} while (0)
#endif
    rwkv_tables(F, p, l, h, false);
    const int w = F.wave, bh = b * 8 + h;
    constexpr int NIT = S / 64;
    volatile LAS unsigned* flg = (volatile LAS unsigned*)(F.lds + LDS_MISC + 128);
    if (F.tid < 4) flg[F.tid] = 0u;
    __syncthreads();
    if (w < 4) {
        f32x4 st[4];
#pragma unroll
        for (int jt = 0; jt < 4; ++jt) st[jt] = (f32x4){0.f, 0.f, 0.f, 0.f};
        u16* YO = (u16*)(p.ws + WS_YB) + (size_t)b * S * D + h * 64;
        __builtin_amdgcn_s_setprio(2);
#pragma unroll 1
        for (int i = 0; i < NIT; ++i) {
            { const unsigned need = 4u * (unsigned)((i >> 1) + 1); while (flg[i & 1] < need) __builtin_amdgcn_s_sleep(0); asm volatile("" ::: "memory"); }
            { int ln_ = F.lane; asm volatile("" : "+v"(ln_)); F.lane = ln_; }
#ifdef PROBE_CHAINSTEPX2
            { f32x4 sv_[4] = {st[0], st[1], st[2], st[3]}; rwkv_chainN<4>(F, st, L + RW_SLOT0 + (i & 1) * 4 * RW_SLOT, YO + (size_t)i * 64 * D, w); st[0] = sv_[0]; st[1] = sv_[1]; st[2] = sv_[2]; st[3] = sv_[3]; }
#endif
            rwkv_chainN<4>(F, st, L + RW_SLOT0 + (i & 1) * 4 * RW_SLOT, YO + (size_t)i * 64 * D, w);
            asm volatile("s_waitcnt lgkmcnt(0)" ::: "memory");
            if (F.lane == 0) __hip_atomic_fetch_add((LAS unsigned*)(F.lds + LDS_MISC + 128) + 2 + (i & 1), 1u, __ATOMIC_RELAXED, __HIP_MEMORY_SCOPE_WORKGROUP);
        }
        __builtin_amdgcn_s_setprio(0);
        CQ_OUT(0, 0, 1); CQ_OUT(0, 1, 2);
    } else {
        __builtin_amdgcn_s_setprio(0);
        const int q = (w - 4) >> 1, sub = (w - 4) & 1;
        HChunk A, B;
        f16x4_t mvr[4];
#pragma unroll
        for (int it = 0; it < 4; ++it) mvr[it] = *(const LAS f16x4_t*)(F.lds + RW_CONSTH + 2 * 128 + (16 * it + 4 * (F.lane >> 4)) * 2);
        LAS unsigned char* slotA = L + RW_SLOT0 + (q * 4 + 2 * sub) * RW_SLOT;
#pragma unroll 1
        for (int k = -1; k < NIT / 2; ++k) {
            const bool act = k >= 0; const int nt_ = 2 * k + 2 + q, ch = 4 * (nt_ < NIT ? nt_ : NIT - 1) + 2 * sub;
            if (act) {
                { const unsigned need = 4u * (unsigned)k; while (flg[2 + q] < need) __builtin_amdgcn_s_sleep(0); asm volatile("" ::: "memory"); }
                H_WAIT(A, 18); h_store(F, A, slotA, (k | q | sub) != 0, mvr);
                asm volatile("" ::: "memory");
                if (F.lane == 0) __hip_atomic_fetch_add((LAS unsigned*)(F.lds + LDS_MISC + 128) + q, 1u, __ATOMIC_RELAXED, __HIP_MEMORY_SCOPE_WORKGROUP);
            }
            h_issue(A, p, bh, ch, F.lane);
            if (act) { H_WAIT(B, 18); h_store(F, B, slotA + RW_SLOT, true, mvr); asm volatile("" ::: "memory");
                if (F.lane == 0) __hip_atomic_fetch_add((LAS unsigned*)(F.lds + LDS_MISC + 128) + q, 1u, __ATOMIC_RELAXED, __HIP_MEMORY_SCOPE_WORKGROUP); }
            h_issue(B, p, bh, ch + 1, F.lane);
        }
        H_WAIT(A, 0); H_WAIT(B, 0);
        __builtin_amdgcn_s_setprio(0);
        CQ_OUT(4, 0, 3); CQ_OUT(4, 1, 4); CQ_OUT(4, 2, 5);
    }
}

__device__ __forceinline__ void p2c_post(Frame& F, CP& p, int l) {
    const u16* PROJ = (const u16*)(p.ws + WS_PROJ); u16* YO = (u16*)(p.ws + WS_YB); const float* BDG = (const float*)(p.ws + WS_BDG);
    LAS float* TB = (LAS float*)F.lds;
    for (int i = F.tid; i < 4 * 512; i += NTHR) { const int a = i >> 9, c = i & 511;
        TB[i] = a == 0 ? p.lnx_g[l * DR + c] : a == 1 ? p.lnx_b[l * DR + c] : a == 2 ? p.mu[l * DSH + PC_V + c] : p.mu[l * DSH + PC_G + c]; }
    __syncthreads();
    const int lane = F.lane, head = lane >> 3, c0 = lane * 8;
    const int gw = F.bid * NWAVES + F.wave, NGW = F.G * NWAVES;
    const __amdgpu_buffer_rsrc_t yb_rsrc = __builtin_amdgcn_make_buffer_rsrc((void*)YO, (short)0, (int)((size_t)M * D * 2), 0x00020000);
    f16x8 nyv[2], nvc[2], ngc[2], nvp, ngp; float nbd[2] = {0.f, 0.f};
    auto load_item = [&](int pr) { const size_t row = (size_t)pr * 2; const bool hasprev = (row & (S - 1)) != 0;
        const u16* pj = PROJ + row * NP; const u16* pp = hasprev ? pj - NP : pj;
#pragma unroll
        for (int hf = 0; hf < 2; ++hf) { nyv[hf] = __builtin_nontemporal_load((const f16x8*)(YO + (row + hf) * D + c0)); nvc[hf] = *(const f16x8*)(pj + hf * NP + PC_V + c0); ngc[hf] = *(const f16x8*)(pj + hf * NP + PC_G + c0);
            nbd[hf] = BDG[(row + hf) * 8 + head]; }
        nvp = *(const f16x8*)(pp + PC_V + c0); ngp = *(const f16x8*)(pp + PC_G + c0); };
    if (gw < M / 2) load_item(gw);
#pragma unroll 1
    for (int pr = gw; pr < M / 2; pr += NGW) {
        const size_t row = (size_t)pr * 2; const bool hasprev = (row & (S - 1)) != 0;
        f16x8 yv[2], vc[2], gc[2], vp[2], gp[2]; float bd[2];
#pragma unroll
        for (int hf = 0; hf < 2; ++hf) { yv[hf] = nyv[hf]; vc[hf] = nvc[hf]; gc[hf] = ngc[hf]; bd[hf] = nbd[hf]; }
        vp[0] = nvp; gp[0] = ngp; vp[1] = vc[0]; gp[1] = gc[0];
        if (pr + NGW < M / 2) load_item(pr + NGW);
#pragma unroll
        for (int hf = 0; hf < 2; ++hf) { const float pm = (hf == 1 || hasprev) ? 1.f : 0.f;
            float y[8]; float s1 = 0.f;
#pragma unroll
            for (int e = 0; e < 8; ++e) { y[e] = (float)yv[hf][e]; s1 += y[e]; }
            s1 += __shfl_xor(s1, 1); s1 += __shfl_xor(s1, 2); s1 += __shfl_xor(s1, 4);
            const float mean = s1 * (1.f / 64.f); float s2 = 0.f;
#pragma unroll
            for (int e = 0; e < 8; ++e) { y[e] -= mean; s2 += y[e] * y[e]; }
            s2 += __shfl_xor(s2, 1); s2 += __shfl_xor(s2, 2); s2 += __shfl_xor(s2, 4);
            const float rstd = rsqrtf(s2 * (1.f / 64.f) + 64e-5f);
            u32x4 ow; unsigned pk[4];
#pragma unroll
            for (int e2 = 0; e2 < 4; ++e2) { float o2[2];
#pragma unroll
                for (int z = 0; z < 2; ++z) { const int e = 2 * e2 + z, c = c0 + e;
                    const float vcur = (float)vc[hf][e], gcur = (float)gc[hf][e];
                    const float v = vcur + TB[1024 + c] * ((float)vp[hf][e] * pm - vcur), g = gcur + TB[1536 + c] * ((float)gp[hf][e] * pm - gcur);
                    const float yn = y[e] * rstd * TB[c] + TB[512 + c] + bd[hf] * v; o2[z] = yn * g * fsig(g); }
                pk[e2] = pk_f16(o2[0], o2[1]); }
            ow.x = pk[0]; ow.y = pk[1]; ow.z = pk[2]; ow.w = pk[3];
            __builtin_amdgcn_raw_buffer_store_b128(ow, yb_rsrc, (int)((row + hf) * (D * 2) + c0 * 2), 0,   16); }
    }
}


__device__ __forceinline__ void p2_mixer(Frame& F, CP& p, int l) {
    if (F.G != 256) {
        if (F.bid < 64) rwkv_unit_chain(F, p, l, F.bid >> 3, F.bid & 7);
        else { for (int u = F.bid - 64; u < NB * NH * 8; u += F.G - 64) attn_wg_unit(F, p, l, u >> 6, (u >> 3) & 7, u & 7);
            if (l + 1 < NL && F.bid >= 192) { __syncthreads(); conv_weights_layer(F, p, l + 1, (F.bid - 192) * NWAVES + F.wave, (F.G - 192) * NWAVES, true, false); } }
        return; }
    constexpr int NATT = NB * NH * 8, NSTAT = 192, NCONV = 64;
    const int nitems = NATT + (l + 1 < NL ? NCONV : 0);
    unsigned* qh = (unsigned*)(p.ws + WS_CTL) + CW_Q + l * 64;
    volatile LAS int* qslot = (volatile LAS int*)(F.lds + LDS_MISC + 64);
    int mine = F.bid - 64;
    if (F.bid < 64) { rwkv_unit_chain(F, p, l, F.bid >> 3, F.bid & 7); if (F.tid == 0) mine = NSTAT + (int)xb_add(qh, 1u); }
#pragma unroll 1
    for (;;) {
        __syncthreads();
        if (F.tid == 0) *qslot = mine;
        __syncthreads();
        const int it = *qslot;
        if (it >= nitems) break;
        if (F.tid == 0) mine = NSTAT + (int)xb_add(qh, 1u);
        if (it < NATT) { int bh, cg; if (it < 384) { bh = it / 6; cg = 2 + it % 6; } else { bh = it & 63; cg = it < 448 ? 1 : 0; }
            attn_wg_unit(F, p, l, bh >> 3, bh & 7, cg); }
        else conv_weights_layer(F, p, l + 1, (it - NATT) * NWAVES + F.wave, NCONV * NWAVES, true, false);
    }
}

__global__ void __launch_bounds__(NTHR, 2) mk_fwd(Params p_) {
    extern __shared__ __attribute__((aligned(16))) unsigned char lds_raw[];
    Frame F; F.lds = (LAS unsigned char*)lds_raw; F.tid = threadIdx.x; F.lane = F.tid & 63; F.wave = __builtin_amdgcn_readfirstlane(F.tid >> 6); F.G = gridDim.x; F.bid = blockIdx.x;
    const int lo = p_.ph_lo, hi = p_.ph_hi;
    int ph = 0;
    volatile LAS unsigned* MISC = (volatile LAS unsigned*)(F.lds + LDS_MISC);
    if (threadIdx.x < 16) MISC[threadIdx.x] = 0u;
    __syncthreads();
    XcdBarrier xbar = xcd_barrier_post((unsigned*)(p_.ws + WS_CTL) + CW_BAR, MISC + 8);
#ifdef TIMING
    unsigned long long tspan[8] = {0,0,0,0,0,0,0,0}; unsigned long long tlast = __builtin_amdgcn_s_memrealtime();
#define TSTAMP(k) do { const unsigned long long now_ = __builtin_amdgcn_s_memrealtime(); tspan[k] += now_ - tlast; tlast = now_; } while (0)
#else
#define TSTAMP(k) do {} while (0)
#endif
#ifdef SPROBE
    float spe_ = 0.f; unsigned long long sp0_ = 0;
#define SP_BEG(id, blk) do { if (SPROBE == (id) && l == 1 && F.bid == (blk)) sp0_ = __builtin_amdgcn_s_memrealtime(); } while (0)
#define SP_END(id, blk) do { if (SPROBE == (id) && l == 1 && F.bid == (blk)) { const float us = 0.01f * (float)(__builtin_amdgcn_s_memrealtime() - sp0_); spe_ = 100.f * exp2f(0.25f * rintf(4.f * log2f(fmaxf(us, 0.01f)))); } } while (0)
#else
#define SP_BEG(id, blk) do {} while (0)
#define SP_END(id, blk) do {} while (0)
#endif
#ifdef GPROBE
    float gpe_ = 0.f; unsigned long long gp0_ = 0; int gpk_ = 0;
#define GP_MARK() do { if (F.bid == 0) { const unsigned long long n_ = __builtin_amdgcn_s_memrealtime(); if (gpk_ == GPROBE) { const float us = 0.01f * (float)(n_ - gp0_); gpe_ = 100.f * exp2f(0.25f * rintf(4.f * log2f(fmaxf(us, 0.01f)))); } gp0_ = n_; } } while (0)
#else
#define GP_MARK() do {} while (0)
#endif
#define PHASE_BEGIN if (ph >= lo && ph < hi) { { int t_ = threadIdx.x; asm volatile("" : "+v"(t_)); F.tid = t_; F.lane = t_ & 63; F.wave = __builtin_amdgcn_readfirstlane(t_ >> 6); } \
    unsigned long long ka_ = (unsigned long long)__builtin_amdgcn_kernarg_segment_ptr(); asm volatile("" : "+s"(ka_)); CP& p = *(CP*)ka_;
#define PHASE_END(last) if (!(last) && ph + 1 < hi) { xcd_barrier(xbar); } } ++ph;
#define PHASE_END_NOWB(k) if (ph + 1 < hi) { if (lo == 0) flat_barrier(xbar, (unsigned)(k)); else xcd_barrier(xbar, false); } } ++ph;
#ifdef TPROBE0
    const unsigned long long tk0_ = __builtin_amdgcn_s_memrealtime(); float tke_ = 0.f;
#define TK(k) do { if (TPROBE0 == (k)) { const float us = 0.01f * (float)(__builtin_amdgcn_s_memrealtime() - tk0_); tke_ = 100.f * exp2f(0.25f * rintf(4.f * log2f(fmaxf(us, 0.01f)))); } } while (0)
#else
#define TK(k) do {} while (0)
#endif
    PHASE_BEGIN p0a_mod(F, p); __syncthreads(); p0a_rest(F, p); TK(2); PHASE_END(false) TSTAMP(0); TK(0);
    PHASE_BEGIN p0b(F, p);
#ifdef PROBE_P0X2
    xcd_barrier(xbar); p0a_mod(F, p); __syncthreads(); p0a_rest(F, p); xcd_barrier(xbar); p0b(F, p);
#endif
    TK(3); PHASE_END(false) TSTAMP(1); TK(1);
    for (int l = 0; l < NL; ++l) {
#ifdef GPROBE
        if (l == 1) { gpk_ = 0; GP_MARK(); }
#define GP_NEXT() do { if (l == 1) { ++gpk_; GP_MARK(); } } while (0)
#else
#define GP_NEXT() do {} while (0)
#endif
        PHASE_BEGIN {
            pg8::Gemm g{(const u16*)(p.ws + WS_AX), (const u16*)(p.ws + WS_WINT), M, NP, D};
            pg8::StaticOrder So; So.init(M, NP, F.G, F.bid);
            SP_BEG(5, 0); SP_BEG(7, 255);
            p1_rstd(F, p, So, l);
            EpiProj E{(u16*)(p.ws + WS_PROJ), (const LAS float*)(F.lds + LDS_SVT), (const LAS float*)(F.lds + LDS_RSTD)};
            pg8::gemm_phase<EpiProj, pg8::StaticOrder, true, true>(F.lds, g, So, E);
            SP_END(5, 0); SP_END(7, 255);
            if (l + 1 < NL && F.bid >= 64) { __syncthreads(); conv_weights_layer(F, p, l + 1, (F.bid - 64) * NWAVES + F.wave, (F.G - 64) * NWAVES, false, true); sw_layer(F, p, l + 1, F.bid - 64, F.G - 64); }
#ifdef PROBE_P1X2
            { int reps = 1; asm volatile("" : "+s"(reps));
#pragma unroll 1
              for (int rep = 0; rep < reps; ++rep) { __syncthreads(); pg8::gemm_phase<EpiProj, pg8::StaticOrder, true, true>(F.lds, g, So, E); } }
#endif
            TSTAMP(2);
        } PHASE_END(false) TSTAMP(3); GP_NEXT();
        PHASE_BEGIN SP_BEG(3, 0); p2a_rwkv_pre(F, p, l); SP_END(3, 0);
#ifdef ATTN_IN_P2A
        __syncthreads(); for (int u = F.bid; u < NB * NH * 8; u += F.G) attn_wg_unit(F, p, l, u >> 6, (u >> 3) & 7, u & 7);
#endif
#ifdef PROBE_P2AX2
        __syncthreads(); p2a_rwkv_pre(F, p, l);
#endif
        PHASE_END_NOWB(2 * l) GP_NEXT();
        PHASE_BEGIN SP_BEG(1, 0); SP_BEG(2, 64); p2_mixer(F, p, l); SP_END(1, 0); SP_END(2, 64);
#ifdef PROBE_P2X2
        __syncthreads(); p2_mixer(F, p, l);
#endif
        TSTAMP(4); PHASE_END(false) TSTAMP(5); GP_NEXT();
#ifdef PROBE_BARX
        for (int r_ = 0; r_ < PROBE_BARX; ++r_) xcd_barrier(xbar);
#endif
        PHASE_BEGIN SP_BEG(4, 0); p2c_post(F, p, l); SP_END(4, 0); PHASE_END_NOWB(2 * l + 1) GP_NEXT();
        PHASE_BEGIN {
            pg8::Gemm g{(const u16*)(p.ws + WS_YB), (const u16*)(p.ws + WS_WOUTT) + (size_t)(l & 1) * D * D, M, D, D};
            pg8::StaticOrder So; So.init(M, D, F.G, F.bid);
            const float* MOD = (const float*)(p.ws + WS_MOD);
            p3_tables(F, p, So, l);
            EpiOut E{l == 0 ? p.x : p.out, p.out, (const LAS float*)(F.lds + LDS_RSTD), (const LAS float*)(F.lds + LDS_RSTD) + 256, l + 1 < NL, (u16*)(p.ws + WS_AX), (float*)(p.ws + WS_PART)};
            SP_BEG(6, 0);
            pg8::gemm_phase<EpiOut, pg8::StaticOrder, true, true>(F.lds, g, So, E);
            SP_END(6, 0);
#ifdef PROBE_P3X2
            { __syncthreads();
              float* dump = (float*)(p.ws + WS_PROJ);
              EpiOut E2{p.x, dump, (const LAS float*)(F.lds + LDS_RSTD), (const LAS float*)(F.lds + LDS_RSTD) + 256, true, (u16*)(p.ws + WS_PROJ + 72 * MiB), dump + 18 * 1024 * 1024 + 9 * 1024 * 1024};
              pg8::gemm_phase<EpiOut, pg8::StaticOrder, true, true>(F.lds, g, So, E2); }
#endif
            TSTAMP(6);
        } PHASE_END(l == NL - 1) TSTAMP(7); GP_NEXT();
    }
#ifdef TPROBE0
    if (F.bid == 0 && F.tid == 0) p.out[0] += tke_;
#endif
#ifdef SPROBE
    if (F.tid == 0 && spe_ != 0.f) p.out[F.bid] += spe_;
#endif
#ifdef GPROBE
    if (F.bid == 0 && F.tid == 0) p.out[0] += gpe_;
#endif
#ifdef CPROBE
    xcd_barrier(xbar);
    if (F.bid == 0 && F.tid == 0) p.out[0] += *((const float*)(p.ws + WS_CTL) + 1024);
#endif
#ifdef APROBE
    xcd_barrier(xbar);
    if (F.bid == 0 && F.tid == 0) p.out[0] += *((const float*)(p.ws + WS_CTL) + 1024);
#endif
#ifdef TPROBE
    xcd_barrier(xbar);
    if (F.bid == 0 && F.tid == 0) p.out[0] += *((const float*)(p.ws + WS_CTL) + 1024);
#endif
#ifdef TIMING
    xcd_barrier(xbar);
    { const float ea = 10.f * 0.01f * (float)tspan[TIM_A], eb = 0.1f * 0.01f * (float)tspan[TIM_B];
      if (F.bid == 0) { const float ea_b = __builtin_bit_cast(float, __builtin_amdgcn_readfirstlane(__builtin_bit_cast(int, ea))), eb_b = __builtin_bit_cast(float, __builtin_amdgcn_readfirstlane(__builtin_bit_cast(int, eb)));
          for (int i = F.tid; i < (1 << 20); i += NTHR) p.out[i] += eb_b + (i == 0 ? ea_b : 0.f); } }
#endif
}

extern "C" void kernel_launch(void* const* d_in, const int* in_sizes, int n_in, void* d_out, int out_size, void* d_ws, size_t ws_size, hipStream_t stream) {
    static int grid = 0;
    if (grid == 0) {
        if (n_in != 20 || out_size != M * D || ws_size < WS_END) { fprintf(stderr, "kernel_launch: unexpected sizes n_in %d out %d ws %zu\n", n_in, out_size, ws_size); grid = -1; return; }
        int dev = 0, cus = 0, per_cu = 0;
        hipGetDevice(&dev); hipDeviceGetAttribute(&cus, hipDeviceAttributeMultiprocessorCount, dev);
        if (hipFuncSetAttribute((const void*)mk_fwd, hipFuncAttributeMaxDynamicSharedMemorySize, LDS_BYTES) != hipSuccess) { fprintf(stderr, "kernel_launch: hipFuncSetAttribute failed\n"); grid = -1; return; }
        if (hipOccupancyMaxActiveBlocksPerMultiprocessor(&per_cu, (const void*)mk_fwd, NTHR, LDS_BYTES) != hipSuccess || per_cu < 1) { fprintf(stderr, "kernel_launch: occupancy query says %d\n", per_cu); per_cu = 1; }
        (void)hipGetLastError();
        grid = cus;
    }
    if (grid < 0) return;
    Params p{};
    (void)hipMemsetAsync(d_ws, 0, 40960, stream);
    const float** pp = (const float**)&p;
    for (int i = 0; i < 20; ++i) pp[i] = (const float*)d_in[i];
    p.out = (float*)d_out; p.ws = (unsigned char*)d_ws;
#ifndef MK_N_PHASE_LAUNCHES
    p.ph_lo = 0; p.ph_hi = 2 + 5 * NL;
    void* args[] = {&p};
    hipError_t e = hipLaunchCooperativeKernel((const void*)mk_fwd, dim3(grid), dim3(NTHR), args, LDS_BYTES, stream);
    if (e != hipSuccess) fprintf(stderr, "cooperative launch failed: %s (grid %d)\n", hipGetErrorString(e), grid);
#else
    for (int ph = 0; ph < 2 + 5 * NL; ++ph) { p.ph_lo = ph; p.ph_hi = ph + 1; hipLaunchKernelGGL(mk_fwd, dim3(grid), dim3(NTHR), LDS_BYTES, stream, p); }
#endif
}
```
